# Optimizing an MI355X kernel written in HIP

```python
import jax, jax.numpy as jnp
from jax import lax
import numpy as np

D_MODEL = 2048
BATCH = 2
SEQ = 8192
DEPTH = 1

N_MEM = 256
GLA_HEADS = 4
GLA_KEY = D_MODEL // 2
GLA_VAL = D_MODEL
GLA_DK = GLA_KEY // GLA_HEADS
GLA_DV = GLA_VAL // GLA_HEADS
GLA_RANK = 16
GLA_TAU = 16.0
HGRN_DK = 128
HGRN_HEADS = D_MODEL // HGRN_DK
HGRN_KEY = HGRN_HEADS * HGRN_DK
HGRN_VAL = D_MODEL
HGRN_DV = HGRN_VAL // HGRN_HEADS
CHUNK = 64
X_HEADS = 4
X_DH = D_MODEL // X_HEADS
N_EXPERTS = 32
TOP_K = 4
D_EXPERT = D_MODEL
SWIGLU_LIMIT = 7.0
SWIGLU_ALPHA = 1.702
MOE_BLOCK = 256
DEEPNORM_ALPHA = (2.0 * DEPTH) ** 0.25
DEEPNORM_BETA = (8.0 * DEPTH) ** -0.25
NORM_EPS = 1e-5

IN_SPLITS = (GLA_KEY, GLA_KEY, GLA_VAL, GLA_VAL, GLA_RANK,
             HGRN_KEY, HGRN_KEY, HGRN_VAL, HGRN_VAL,
             D_MODEL, D_MODEL)
D_IN = sum(IN_SPLITS)
SPLIT_OFFSETS = tuple(int(o) for o in np.cumsum(IN_SPLITS)[:-1])

kernel_name = "hybrid_gla_hgrn2_deepnorm_memxattn_moe"


def layer_norm(x, g, b):
    xf = x.astype(jnp.float32)
    mu = jnp.mean(xf, axis=-1, keepdims=True)
    var = jnp.mean(jnp.square(xf - mu), axis=-1, keepdims=True)
    return ((xf - mu) * lax.rsqrt(var + NORM_EPS) * g + b).astype(x.dtype)


def head_rmsnorm(o, g):
    return o * lax.rsqrt(jnp.mean(jnp.square(o), axis=-1, keepdims=True) + NORM_EPS) * g.astype(jnp.float32)


def to_heads(t, n_heads):
    b, s, _ = t.shape
    return t.reshape(b, s, n_heads, -1).transpose(0, 2, 1, 3)


def from_heads(t):
    b, h, s, d = t.shape
    return t.transpose(0, 2, 1, 3).reshape(b, s, h * d)


def chunked_gated_linear_attention(q, k, v, log_g):
    b, h, s, dk = q.shape
    dv = v.shape[-1]
    n_chunks = s // CHUNK

    def to_chunks(t):
        return t.astype(jnp.float32).reshape(b, h, n_chunks, CHUNK, t.shape[-1]).transpose(2, 0, 1, 3, 4)

    causal = jnp.tril(jnp.ones((CHUNK, CHUNK), dtype=bool))[:, :, None]

    def step(state, inp):
        qc, kc, vc, gc = inp
        cum = jnp.cumsum(gc, axis=2)
        o_inter = jnp.einsum("bhcd,bhde->bhce", qc * jnp.exp(cum), state)
        diff = cum[:, :, :, None, :] - cum[:, :, None, :, :]
        decay = jnp.exp(jnp.where(causal, diff, -jnp.inf))
        scores = jnp.einsum("bhid,bhjd,bhijd->bhij", qc, kc, decay)
        o_intra = jnp.einsum("bhij,bhje->bhie", scores, vc)
        last = cum[:, :, -1:, :]
        new_state = (jnp.exp(last)[:, :, 0, :, None] * state
                     + jnp.einsum("bhcd,bhce->bhde", kc * jnp.exp(last - cum), vc))
        return new_state, o_inter + o_intra

    state0 = jnp.zeros((b, h, dk, dv), jnp.float32)
    _, o = lax.scan(step, state0, (to_chunks(q), to_chunks(k), to_chunks(v), to_chunks(log_g)))
    return o.transpose(1, 2, 0, 3, 4).reshape(b, h, s, dv)


def token_mixer(h, w_in, b_in, w_gla_a2, b_gla_a, gla_norm_g, hgrn_norm_g, hgrn_lb, w_o):
    dt = h.dtype
    proj = h @ w_in + b_in
    gq, gk, gv, gr, ga1, hq, hf, hi, hg, m_a, m_b = jnp.split(proj, SPLIT_OFFSETS, axis=-1)

    log_alpha = jax.nn.log_sigmoid((ga1 @ w_gla_a2 + b_gla_a).astype(jnp.float32)) / GLA_TAU
    o_gla = chunked_gated_linear_attention(
        to_heads(gq.astype(jnp.float32) * GLA_DK ** -0.5, GLA_HEADS), to_heads(gk, GLA_HEADS),
        to_heads(gv, GLA_HEADS), to_heads(log_alpha, GLA_HEADS))
    o_gla = from_heads(head_rmsnorm(o_gla, gla_norm_g)) * jax.nn.silu(gr.astype(jnp.float32))

    log_f = jnp.logaddexp(jnp.log(hgrn_lb), jnp.log1p(-hgrn_lb) + jax.nn.log_sigmoid(hf.astype(jnp.float32)))
    k_h = -jnp.expm1(log_f)
    o_h = chunked_gated_linear_attention(
        to_heads(jax.nn.silu(hq.astype(jnp.float32)), HGRN_HEADS), to_heads(k_h, HGRN_HEADS),
        to_heads(hi, HGRN_HEADS), to_heads(log_f, HGRN_HEADS))
    o_h = from_heads(head_rmsnorm(o_h, hgrn_norm_g)) * jax.nn.sigmoid(hg.astype(jnp.float32))

    merged = (jax.nn.sigmoid(m_a.astype(jnp.float32)) * o_gla
              + jax.nn.sigmoid(m_b.astype(jnp.float32)) * o_h)
    return merged.astype(dt) @ w_o


def memory_cross_attention(h, mem, w_xq, w_mem_kv, w_xo):
    b, s, d = h.shape
    q = (h @ w_xq).reshape(b, s, X_HEADS, X_DH)
    k, v = jnp.split(mem @ w_mem_kv, 2, axis=-1)
    k = k.reshape(b, N_MEM, X_HEADS, X_DH)
    v = v.reshape(b, N_MEM, X_HEADS, X_DH)
    scores = jnp.einsum("bshd,bmhd->bhsm", q, k).astype(jnp.float32) * X_DH ** -0.5
    p = jax.nn.softmax(scores, axis=-1)
    o = jnp.einsum("bhsm,bmhd->bshd", p.astype(v.dtype), v).reshape(b, s, d)
    return o @ w_xo


def clamped_swiglu(gu):
    glu = jnp.minimum(gu[..., ::2], SWIGLU_LIMIT)
    lin = jnp.clip(gu[..., 1::2], -SWIGLU_LIMIT, SWIGLU_LIMIT)
    return glu * jax.nn.sigmoid(SWIGLU_ALPHA * glu) * (lin + 1.0)


def moe(h, w_router, b_router, w_gate_up, b_gate_up, w_down, b_down):
    b, s, d = h.shape
    n_tok = b * s
    n_assign = n_tok * TOP_K
    xt = h.reshape(n_tok, d)
    logits = (xt @ w_router + b_router).astype(jnp.float32)
    top_logit, top_e = lax.top_k(logits, TOP_K)
    gate = jax.nn.softmax(top_logit, axis=-1)

    e_flat = top_e.reshape(n_assign)
    tok_flat = jnp.repeat(jnp.arange(n_tok, dtype=jnp.int32), TOP_K)
    order = jnp.argsort(e_flat)
    e_sorted = e_flat[order]
    tok_sorted = tok_flat[order]
    gate_sorted = gate.reshape(n_assign)[order]
    counts = jnp.bincount(e_flat, length=N_EXPERTS)
    start = jnp.cumsum(counts) - counts
    padded = (counts + MOE_BLOCK - 1) // MOE_BLOCK * MOE_BLOCK
    pend = jnp.cumsum(padded)
    pstart = pend - padded
    dest = pstart[e_sorted] + jnp.arange(n_assign, dtype=jnp.int32) - start[e_sorted]
    n_blocks = -(-n_assign // MOE_BLOCK) + N_EXPERTS
    n_rows = n_blocks * MOE_BLOCK
    row_tok = jnp.full((n_rows,), n_tok, jnp.int32).at[dest].set(tok_sorted)
    row_gate = jnp.zeros((n_rows,), jnp.float32).at[dest].set(gate_sorted)
    block_e = jnp.minimum(jnp.searchsorted(pend, jnp.arange(n_blocks) * MOE_BLOCK, side="right"),
                          N_EXPERTS - 1)
    x_pad = jnp.concatenate([xt, jnp.zeros((1, d), xt.dtype)], axis=0)

    def block_step(acc, inp):
        rows, rgate, e = inp
        xb = x_pad[rows]
        gu = xb @ w_gate_up[e] + b_gate_up[e]
        yb = clamped_swiglu(gu) @ w_down[e] + b_down[e]
        return acc.at[rows].add(yb.astype(jnp.float32) * rgate[:, None]), None

    acc0 = jnp.zeros((n_tok + 1, d), jnp.float32)
    acc, _ = lax.scan(block_step, acc0, (row_tok.reshape(n_blocks, MOE_BLOCK),
                                         row_gate.reshape(n_blocks, MOE_BLOCK), block_e))
    return acc[:n_tok].astype(h.dtype).reshape(b, s, d)


def setup_inputs(seed: int = 0) -> dict:
    key = jax.random.key(seed)
    ks = jax.random.split(key, 25)
    f32 = jnp.float32

    def nrm(k, shape, scale):
        return jax.random.normal(k, shape, f32) * scale

    L = DEPTH
    return {
        "x": nrm(ks[0], (BATCH, SEQ, D_MODEL), 1.0),
        "mem": nrm(ks[1], (BATCH, N_MEM, D_MODEL), 1.0),
        "w_in": nrm(ks[2], (L, D_MODEL, D_IN), D_MODEL ** -0.5),
        "b_in": nrm(ks[3], (L, D_IN), 0.01),
        "w_gla_a2": nrm(ks[4], (L, GLA_RANK, GLA_KEY), GLA_RANK ** -0.5),
        "b_gla_a": nrm(ks[5], (L, GLA_KEY), 0.01),
        "gla_norm_g": 1.0 + nrm(ks[6], (L, GLA_DV), 0.01),
        "hgrn_norm_g": 1.0 + nrm(ks[7], (L, HGRN_DV), 0.01),
        "hgrn_lb_logits": nrm(ks[8], (L + 1, HGRN_KEY), 0.1),
        "w_mix_o": nrm(ks[9], (L, GLA_VAL, D_MODEL), GLA_VAL ** -0.5 * DEEPNORM_BETA),
        "w_xq": nrm(ks[10], (L, D_MODEL, D_MODEL), D_MODEL ** -0.5),
        "w_mem_kv": nrm(ks[11], (L, D_MODEL, 2 * D_MODEL), D_MODEL ** -0.5),
        "w_xo": nrm(ks[12], (L, D_MODEL, D_MODEL), D_MODEL ** -0.5 * DEEPNORM_BETA),
        "w_router": nrm(ks[13], (L, D_MODEL, N_EXPERTS), D_MODEL ** -0.5),
        "b_router": nrm(ks[14], (L, N_EXPERTS), 0.01),
        "w_gate_up": nrm(ks[15], (L, N_EXPERTS, D_MODEL, 2 * D_EXPERT), D_MODEL ** -0.5),
        "b_gate_up": nrm(ks[16], (L, N_EXPERTS, 2 * D_EXPERT), 0.01),
        "w_down": nrm(ks[17], (L, N_EXPERTS, D_EXPERT, D_MODEL), D_EXPERT ** -0.5 * DEEPNORM_BETA),
        "b_down": nrm(ks[18], (L, N_EXPERTS, D_MODEL), 0.01),
        "ln1_g": 1.0 + nrm(ks[19], (L, D_MODEL), 0.01),
        "ln1_b": nrm(ks[20], (L, D_MODEL), 0.01),
        "ln2_g": 1.0 + nrm(ks[21], (L, D_MODEL), 0.01),
        "ln2_b": nrm(ks[22], (L, D_MODEL), 0.01),
        "ln3_g": 1.0 + nrm(ks[23], (L, D_MODEL), 0.01),
        "ln3_b": nrm(ks[24], (L, D_MODEL), 0.01),
    }


def reference(x, mem, w_in, b_in, w_gla_a2, b_gla_a, gla_norm_g, hgrn_norm_g, hgrn_lb_logits,
              w_mix_o, w_xq, w_mem_kv, w_xo, w_router, b_router, w_gate_up, b_gate_up,
              w_down, b_down, ln1_g, ln1_b, ln2_g, ln2_b, ln3_g, ln3_b):
    lb_table = jnp.cumsum(jax.nn.softmax(hgrn_lb_logits.astype(jnp.float32), axis=0), axis=0)
    h = x
    for l in range(DEPTH):
        mix = token_mixer(h, w_in[l], b_in[l], w_gla_a2[l], b_gla_a[l], gla_norm_g[l],
                          hgrn_norm_g[l], lb_table[l], w_mix_o[l])
        h = layer_norm(DEEPNORM_ALPHA * h + mix, ln1_g[l], ln1_b[l])
        xat = memory_cross_attention(h, mem, w_xq[l], w_mem_kv[l], w_xo[l])
        h = layer_norm(DEEPNORM_ALPHA * h + xat, ln2_g[l], ln2_b[l])
        ffn = moe(h, w_router[l], b_router[l], w_gate_up[l], b_gate_up[l], w_down[l], b_down[l])
        h = layer_norm(DEEPNORM_ALPHA * h + ffn, ln3_g[l], ln3_b[l])
    return h
```

```cpp
#include <hip/hip_runtime.h>
#include <cstdio>
#include <cstdint>

#ifndef MK_ONE_LAUNCH
#define MK_ONE_LAUNCH 1
#endif

#define GAS __attribute__((address_space(1)))
#define LAS __attribute__((address_space(3)))
typedef unsigned short bf16;
typedef unsigned v4u __attribute__((ext_vector_type(4)));
typedef unsigned v2u __attribute__((ext_vector_type(2)));
typedef float f32x4 __attribute__((ext_vector_type(4)));
typedef float f32x2 __attribute__((ext_vector_type(2)));
typedef short bf16x8 __attribute__((ext_vector_type(8)));
#define RLX_AGENT __ATOMIC_RELAXED, __HIP_MEMORY_SCOPE_AGENT
#define LDS_WAIT() asm volatile("s_waitcnt lgkmcnt(0)" ::: "memory")
#define VM_WAIT() asm volatile("s_waitcnt vmcnt(0)" ::: "memory")

constexpr int D = 2048, NBATCH = 2, SEQ = 8192, T = NBATCH * SEQ;
constexpr int DIN = 18448, NPROJ = 18432;
constexpr int GQ = 0, GK = 1024, GV = 2048, GR = 4096, HQ = 6144, HF = 8192, HI = 10240, HG = 12288, MA = 14336, MB = 16384;
constexpr int GA1_COL = 6144;
constexpr int NE = 32, TOPK = 4, NMEM = 256, XH = 4, XDH = 512;
constexpr int MOE_CAP = 16384, MOE_MAXTILES = 288;
constexpr float ALPHA = 1.189207115002721f;
constexpr float EPS = 1e-5f;
constexpr int NWAVES = 8, NTHREADS = 512;

#ifndef FP8_EXTRA
#define FP8_EXTRA 8, 9, 10, 11, 12, 13, 14, 15, 16, 17, 18, 19, 20, 21, 22, 23, 24, 25, 26, 27, 28, 29, 30, 31, 40, 41, 42, 43, 44, 45, 46, 47,
#endif
__device__ const unsigned char TILES_FP8[] = {FP8_EXTRA 32, 33, 34, 35, 36, 37, 38, 39, 48, 49, 50, 51, 52, 53, 54, 55, 56, 57, 58, 59, 60, 61, 62, 63, 64, 65, 66, 67, 68, 69, 70, 71};
constexpr int N_FP8_TILES = sizeof(TILES_FP8);
constexpr int N_BF16_TILES = 72 - N_FP8_TILES;
constexpr size_t MiB = 1u << 20;
constexpr size_t WS_CTL = 0, CTL_ZERO_BYTES = 1 * MiB;
constexpr size_t WS_WIN_T = 1 * MiB;
constexpr size_t WS_WO_T = WS_WIN_T + 72 * MiB;
constexpr size_t WS_WXQ_T = WS_WO_T + 8 * MiB;
constexpr size_t WS_WKV_T = WS_WXQ_T + 8 * MiB;
constexpr size_t WS_WXO_T = WS_WKV_T + 16 * MiB;
constexpr size_t WS_WGU_T = WS_WXO_T + 8 * MiB;
constexpr size_t WS_WD_T = WS_WGU_T + 512 * MiB;
constexpr size_t WS_XB = WS_WD_T + 256 * MiB;
constexpr size_t WS_MEMB = WS_XB + 64 * MiB;
constexpr size_t WS_GA1 = WS_MEMB + 2 * MiB;
constexpr size_t WS_BINC = WS_GA1 + 1 * MiB;
constexpr size_t WS_BGUP = WS_BINC + 1 * MiB;
constexpr size_t WS_LB = WS_BGUP + 1 * MiB;
constexpr size_t WS_PROJ = WS_LB + 1 * MiB;
constexpr size_t WS_GLOG = WS_PROJ + 576 * MiB;
constexpr size_t WS_OGLA = WS_GLOG + 64 * MiB;
constexpr size_t WS_OH = WS_OGLA + 128 * MiB;
constexpr size_t WS_MERGED = WS_OH + 128 * MiB;
constexpr size_t WS_PRE1 = WS_MERGED + 64 * MiB;
constexpr size_t WS_H1 = WS_PRE1 + 128 * MiB;
constexpr size_t WS_H1B = WS_H1 + 128 * MiB;
constexpr size_t WS_STAT = WS_H1 + 64 * MiB;
constexpr size_t WS_FST = WS_H1 + 72 * MiB;
constexpr size_t WS_WRH = WS_H1 + 88 * MiB;
constexpr size_t WS_WRL = WS_H1 + 89 * MiB;
constexpr size_t WS_ST2 = WS_H1 + 90 * MiB;
constexpr size_t WS_C12 = WS_H1 + 80 * MiB;
constexpr size_t WS_Q = WS_H1B + 64 * MiB;
constexpr size_t WS_KK = WS_Q + 64 * MiB;
constexpr size_t WS_VT = WS_KK + 2 * MiB;
constexpr size_t WS_SC = WS_VT + 2 * MiB;
constexpr size_t WS_P = WS_SC + 64 * MiB;
constexpr size_t WS_AO = WS_P + 32 * MiB;
constexpr size_t WS_PRE2 = WS_AO + 64 * MiB;
constexpr size_t WS_H2 = WS_PRE2 + 128 * MiB;
constexpr size_t WS_H2B = WS_H2 + 128 * MiB;
constexpr size_t WS_LIST = WS_H2B + 64 * MiB;
constexpr size_t WS_GATES = WS_LIST + 2 * MiB;
constexpr size_t WS_ACT = WS_GATES + 1 * MiB;
constexpr size_t WS_YBUF = WS_ACT + 288 * MiB;
constexpr size_t WS_QFG = WS_YBUF + 256 * MiB;
constexpr size_t WS_KFG = WS_QFG + 32 * MiB;
constexpr size_t WS_PFG = WS_KFG + 32 * MiB;
constexpr size_t WS_LAMG = WS_PFG + 6 * MiB;
constexpr size_t WS_VFG = WS_LAMG + 1 * MiB;
constexpr size_t WS_QFH = WS_VFG + 64 * MiB;
constexpr size_t WS_KFH = WS_QFH + 64 * MiB;
constexpr size_t WS_PFH = WS_KFH + 64 * MiB;
constexpr size_t WS_LAMH = WS_PFH + 24 * MiB;
constexpr size_t WS_VFH = WS_LAMH + 4 * MiB;
constexpr size_t WS_END = WS_VFH + 64 * MiB + 1 * MiB;
constexpr int CW_TMO = 0;
constexpr int CW_CNT = 64;
constexpr int CW_HQ = 256;
constexpr int CW_BAR = 4096;

constexpr int RING_BYTES = 131072;
constexpr int LDS_BYTES = 163840;
constexpr int MISC_OFF = LDS_BYTES - 1024;
constexpr int MOETAB_OFF = MISC_OFF + 256;
constexpr int SCAN_STAGE = 76800;
static_assert(2 * SCAN_STAGE <= MISC_OFF, "scan stages below the control words");

__device__ __forceinline__ float bf2f(unsigned b) { return __uint_as_float(b << 16); }
__device__ __forceinline__ unsigned f2bf(float f) { unsigned u = __float_as_uint(f); return (u + 0x7fffu + ((u >> 16) & 1u)) >> 16; }
typedef __bf16 bf16x2_hw __attribute__((ext_vector_type(2)));
__device__ __forceinline__ unsigned pk2(float lo, float hi) { f32x2 v = {lo, hi}; return __builtin_bit_cast(unsigned, __builtin_convertvector(v, bf16x2_hw)); }
__device__ __forceinline__ float sigmoidf_(float x) { return __builtin_amdgcn_rcpf(1.0f + __expf(-x)); }
__device__ __forceinline__ float logsigmoidf_(float z) { return z < 0.f ? z - log1pf(__expf(z)) : -log1pf(__expf(-z)); }
__device__ __forceinline__ float wave_sum(float v) {
#pragma unroll
    for (int o = 1; o < 64; o <<= 1) v += __shfl_xor(v, o);
    return v;
}
__device__ __forceinline__ float wave_max(float v) {
#pragma unroll
    for (int o = 1; o < 64; o <<= 1) v = fmaxf(v, __shfl_xor(v, o));
    return v;
}

namespace pg8 {
constexpr int BM = 256, BK = 64, HALF = 128, HTB = HALF * BK * 2, STAGE_BYTES = 8 * HTB, NXCD = 8, WGM = 8;
__host__ __device__ __forceinline__ int lds_byte(int r, int c) { const int st = (r >> 4) * 2 + (c >> 5), rr = r & 15, cc = c & 31, ob = rr * 64 + cc * 2; return st * 1024 + (ob ^ (((ob >> 9) & 1) << 5)); }
__host__ __device__ __forceinline__ void stage_rc(int b, int& R, int& C) { const int st = b / 1024, sb = b % 1024, swz = sb ^ (((sb >> 9) & 1) << 5); R = (st >> 1) * 16 + swz / 64; C = (st & 1) * 32 + (swz % 64) / 2; }
__host__ __device__ __forceinline__ int perm32(int rho) { const int n = rho >> 4, i = rho & 15; return 8 * (i >> 2) + 4 * n + (i & 3); }

struct Unit { int pm, pn, e, mt, rows, idx; };

__device__ __forceinline__ bool static_next(int nM, int nN, int G, int c, int i, Unit& u) {
    const int nwg = nM * nN; const long L = (long)i * G + c; if (L >= nwg) return false;
    int wgid = (int)L; { const int q = nwg / NXCD, r = nwg % NXCD, xcd = wgid % NXCD, off = wgid / NXCD; wgid = (xcd < r ? xcd * (q + 1) : r * (q + 1) + (xcd - r) * q) + off; }
    const int nig = WGM * nN, gid = wgid / nig, fm = gid * WGM, gsz = (nM - fm) < WGM ? (nM - fm) : WGM;
    u.pm = fm + ((wgid % nig) % gsz); u.pn = (wgid % nig) / gsz; u.e = 0; u.mt = 0; u.rows = 256; u.idx = i; return true;
}

__device__ __forceinline__ unsigned cvt_pk_bf16(float lo, float hi) { unsigned r; asm volatile("v_cvt_pk_bf16_f32 %0, %1, %2" : "=v"(r) : "v"(lo), "v"(hi)); return r; }

typedef f32x4 Acc[2][2][4][2];

typedef int i32x4_t __attribute__((ext_vector_type(4)));
typedef int i32x8_t __attribute__((ext_vector_type(8)));
__device__ __forceinline__ i32x8_t cat8(bf16x8 a, bf16x8 b) { return __builtin_shufflevector(__builtin_bit_cast(i32x4_t, a), __builtin_bit_cast(i32x4_t, b), 0, 1, 2, 3, 4, 5, 6, 7); }
template <class Epi, class Sched, bool GATHER, int ESZ = 2>
__device__ __forceinline__ void gemm_phase(LAS unsigned char* lds, const int K, const int lda, const int ldb, const Sched& S, const Epi& E) {
    int tid_ = threadIdx.x; asm volatile("" : "+v"(tid_));
    const int tid = tid_, wid = __builtin_amdgcn_readfirstlane(tid >> 6), lane = tid & 63, wr = wid >> 2, wc = wid & 3, fr = lane & 15, fq = lane >> 4;
    const int nt = K * ESZ / 128;
    unsigned voffA[2], voffB[2]; int RA[2]; unsigned CA2[2];
#pragma unroll
    for (int i = 0; i < 2; ++i) { int R, C; stage_rc(tid * 16 + i * 8192, R, C); const int Rb = Epi::PERM ? ((R & ~31) + perm32(R & 31)) : R;
        voffA[i] = (unsigned)(R * lda * ESZ + C * 2); voffB[i] = (unsigned)(Rb * ldb * ESZ + C * 2); RA[i] = R; CA2[i] = (unsigned)C * 2u; }
    const size_t kstep = (size_t)(BK * 2);
    const size_t hstepA = (size_t)HALF * lda * ESZ, hstepB = (size_t)HALF * ldb * ESZ;
    const unsigned ldsw = (unsigned)wid * 1024u;
    const int aoff = lds_byte(wr * 64 + fr, fq * 8), boff = lds_byte(wc * 32 + fr, fq * 8);
#define PG8_SA(b, h) (((b) * 2 + (h)) * HTB)
#define PG8_SB(b, h) ((4 + (b) * 2 + (h)) * HTB)
#define PG8_STAGE_RAW(bufoff, gptr, o0, o1) do { \
        __builtin_amdgcn_global_load_lds((const unsigned*)((const char*)(gptr) + (o0)), (LAS unsigned*)(lds + (bufoff) + ldsw), 16, 0, 0); \
        __builtin_amdgcn_global_load_lds((const unsigned*)((const char*)(gptr) + (o1)), (LAS unsigned*)(lds + (bufoff) + ldsw + 8192), 16, 0, 0); } while (0)
#define PG8_STAGE_B(bufoff, gptr) PG8_STAGE_RAW(bufoff, gptr, voffB[0], voffB[1])
#define PG8_STAGE_A_CUR(bufoff, kptr, half) do { if constexpr (GATHER) { if ((half) == 0) PG8_STAGE_RAW(bufoff, kptr, vAc0[0], vAc0[1]); else PG8_STAGE_RAW(bufoff, kptr, vAc1[0], vAc1[1]); } \
        else { PG8_STAGE_RAW(bufoff, (kptr) + (half) * hstepA, voffA[0], voffA[1]); } } while (0)
#define PG8_STAGE_A_SEL(bufoff, kptr, half) do { if constexpr (GATHER) { if ((half) == 0) PG8_STAGE_RAW(bufoff, kptr, (last ? vAn0[0] : vAc0[0]), (last ? vAn0[1] : vAc0[1])); else PG8_STAGE_RAW(bufoff, kptr, (last ? vAn1[0] : vAc1[0]), (last ? vAn1[1] : vAc1[1])); } \
        else { PG8_STAGE_RAW(bufoff, (kptr) + (half) * hstepA, voffA[0], voffA[1]); } } while (0)
#define PG8_LDA(dst, b, h) do { _Pragma("unroll") for (int m = 0; m < 4; ++m) { const i32x4_t lo_ = *(const LAS i32x4_t*)(lds + PG8_SA(b, h) + aoff + m * 2048), hi_ = *(const LAS i32x4_t*)(lds + PG8_SA(b, h) + aoff + m * 2048 + 1024); dst[m] = __builtin_shufflevector(lo_, hi_, 0, 1, 2, 3, 4, 5, 6, 7); } } while (0)
#define PG8_LDB(dst, b, h) do { _Pragma("unroll") for (int n = 0; n < 2; ++n) { const i32x4_t lo_ = *(const LAS i32x4_t*)(lds + PG8_SB(b, h) + boff + n * 2048), hi_ = *(const LAS i32x4_t*)(lds + PG8_SB(b, h) + boff + n * 2048 + 1024); dst[n] = __builtin_shufflevector(lo_, hi_, 0, 1, 2, 3, 4, 5, 6, 7); } } while (0)
#define PG8_LO(x) __builtin_bit_cast(bf16x8, __builtin_shufflevector(x, x, 0, 1, 2, 3))
#define PG8_HI(x) __builtin_bit_cast(bf16x8, __builtin_shufflevector(x, x, 4, 5, 6, 7))
#define PG8_MMA(ai, bj, At, Bt) do { __builtin_amdgcn_s_setprio(1); if constexpr (ESZ == 2) { _Pragma("unroll") for (int m = 0; m < 4; ++m) _Pragma("unroll") for (int n = 0; n < 2; ++n) { \
        acc[ai][bj][m][n] = __builtin_amdgcn_mfma_f32_16x16x32_bf16(PG8_LO(Bt[n]), PG8_LO(At[m]), acc[ai][bj][m][n], 0, 0, 0); acc[ai][bj][m][n] = __builtin_amdgcn_mfma_f32_16x16x32_bf16(PG8_HI(Bt[n]), PG8_HI(At[m]), acc[ai][bj][m][n], 0, 0, 0); } } \
        else { _Pragma("unroll") for (int m = 0; m < 4; ++m) _Pragma("unroll") for (int n = 0; n < 2; ++n) \
        asm volatile("v_mfma_scale_f32_16x16x128_f8f6f4 %0, %1, %2, %0, %3, %3 op_sel_hi:[0,0,0]" : "+v"(acc[ai][bj][m][n]) : "v"(Bt[n]), "v"(At[m]), "v"(mx_one)); } __builtin_amdgcn_s_setprio(0); } while (0)
#define PG8_WAIT_V(n) asm volatile("s_waitcnt vmcnt(" #n ")" ::: "memory")
#define PG8_WAIT_L(n) asm volatile("s_waitcnt lgkmcnt(" #n ")" ::: "memory")
#define PG8_BAR __builtin_amdgcn_s_barrier()
#define PG8_SCHED __builtin_amdgcn_sched_barrier(0)
    Unit cur, nxt; int ui = 0;
    if (!S.next(0, cur)) return;
    Acc acc;
#pragma unroll
    for (int a = 0; a < 2; ++a)
#pragma unroll
        for (int b = 0; b < 2; ++b)
#pragma unroll
            for (int m = 0; m < 4; ++m)
#pragma unroll
                for (int n = 0; n < 2; ++n) acc[a][b][m][n] = (f32x4){0.f, 0.f, 0.f, 0.f};
    i32x8_t At[4], B0[2], B1[2];
    const int mx_one = 0x7F7F7F7F;
    const char* cA = S.a_base(cur); const char* cB = S.b_base(cur);
    unsigned vAc0[2] = {0u, 0u}, vAc1[2] = {0u, 0u}, vAn0[2] = {0u, 0u}, vAn1[2] = {0u, 0u};
    if constexpr (GATHER) {
#pragma unroll
        for (int i = 0; i < 2; ++i) { vAc0[i] = S.row_off(cur, RA[i]) + CA2[i]; vAc1[i] = S.row_off(cur, HALF + RA[i]) + CA2[i]; }
    }
    PG8_STAGE_B(PG8_SB(0, 0), cB); PG8_STAGE_B(PG8_SB(0, 1), cB + hstepB); PG8_STAGE_A_CUR(PG8_SA(0, 0), cA, 0); PG8_STAGE_A_CUR(PG8_SA(0, 1), cA, 1);
    if (wr == 1) PG8_BAR;
    PG8_WAIT_V(2); PG8_BAR;
    PG8_STAGE_B(PG8_SB(1, 0), cB + kstep); PG8_STAGE_A_CUR(PG8_SA(1, 0), cA + kstep, 0); PG8_STAGE_B(PG8_SB(1, 1), cB + hstepB + kstep);
    PG8_WAIT_V(6); PG8_BAR;
    for (;;) {
        const bool has_next = S.next(ui + 1, nxt);
        const char* nA = has_next ? S.a_base(nxt) : cA; const char* nB = has_next ? S.b_base(nxt) : cB;
        if constexpr (GATHER) {
            if (has_next) {
#pragma unroll
                for (int i = 0; i < 2; ++i) { vAn0[i] = S.row_off(nxt, RA[i]) + CA2[i]; vAn1[i] = S.row_off(nxt, HALF + RA[i]) + CA2[i]; }
            } else {
#pragma unroll
                for (int i = 0; i < 2; ++i) { vAn0[i] = vAc0[i]; vAn1[i] = vAc1[i]; }
            }
        }
#pragma nounroll
        for (int t = 0; t < nt; t += 2) {
            const bool last = (t == nt - 2);
            const char* a1 = cA + (size_t)(t + 1) * kstep;
            const char* a2 = last ? nA : cA + (size_t)(t + 2) * kstep; const char* b2 = last ? nB : cB + (size_t)(t + 2) * kstep;
            const char* a3 = a2 + kstep; const char* b3 = b2 + kstep;
            PG8_LDB(B0, 0, 0); PG8_LDB(B1, 0, 1); PG8_SCHED; PG8_LDA(At, 0, 0); PG8_STAGE_A_CUR(PG8_SA(1, 1), a1, 1);
            PG8_WAIT_V(8); PG8_WAIT_L(0); PG8_BAR; PG8_MMA(0, 0, At, B0); PG8_MMA(0, 1, At, B1); PG8_BAR; PG8_SCHED;
            PG8_LDA(At, 0, 1); PG8_STAGE_B(PG8_SB(0, 0), b2); PG8_STAGE_B(PG8_SB(0, 1), b2 + hstepB); PG8_STAGE_A_SEL(PG8_SA(0, 0), a2, 0);
            PG8_WAIT_V(8); PG8_WAIT_L(0); PG8_BAR; if (!(Sched::HALF_SKIP && cur.rows <= HALF)) { PG8_MMA(1, 0, At, B0); PG8_MMA(1, 1, At, B1); } PG8_BAR; PG8_SCHED;
            PG8_LDB(B0, 1, 0); PG8_LDB(B1, 1, 1); PG8_SCHED; PG8_LDA(At, 1, 0); PG8_STAGE_A_SEL(PG8_SA(0, 1), a2, 1);
            PG8_WAIT_V(8); PG8_WAIT_L(0); PG8_BAR; PG8_MMA(0, 0, At, B0); PG8_MMA(0, 1, At, B1); PG8_BAR; PG8_SCHED;
            PG8_LDA(At, 1, 1); PG8_STAGE_B(PG8_SB(1, 0), b3); PG8_STAGE_B(PG8_SB(1, 1), b3 + hstepB); PG8_STAGE_A_SEL(PG8_SA(1, 0), a3, 0);
            PG8_WAIT_V(8); PG8_WAIT_L(0); PG8_BAR; if (!(Sched::HALF_SKIP && cur.rows <= HALF)) { PG8_MMA(1, 0, At, B0); PG8_MMA(1, 1, At, B1); } PG8_BAR; PG8_SCHED;
        }
        if (wr == 0) PG8_BAR;
        if constexpr (ESZ == 1) asm volatile("s_nop 15\n\ts_nop 15" ::: "memory");
        E(acc, cur, wr, wc, fr, fq);
        if (!has_next) break;
#pragma unroll
        for (int a = 0; a < 2; ++a)
#pragma unroll
            for (int b = 0; b < 2; ++b)
#pragma unroll
                for (int m = 0; m < 4; ++m)
#pragma unroll
                    for (int n = 0; n < 2; ++n) acc[a][b][m][n] = (f32x4){0.f, 0.f, 0.f, 0.f};
        cur = nxt; cA = nA; cB = nB; ++ui;
        if constexpr (GATHER) {
#pragma unroll
            for (int i = 0; i < 2; ++i) { vAc0[i] = vAn0[i]; vAc1[i] = vAn1[i]; }
        }
        if (wr == 1) PG8_BAR;
    }
    PG8_WAIT_V(0);
    PG8_BAR;
#undef PG8_SA
#undef PG8_SB
#undef PG8_STAGE_RAW
#undef PG8_STAGE_B
#undef PG8_STAGE_A_CUR
#undef PG8_STAGE_A_SEL
#undef PG8_LDA
#undef PG8_LDB
#undef PG8_MMA
#undef PG8_LO
#undef PG8_HI
#undef PG8_WAIT_V
#undef PG8_WAIT_L
#undef PG8_BAR
#undef PG8_SCHED
}

struct SchedDense {
    static constexpr bool HALF_SKIP = false;
    const char* A; const char* Bt; int nM, nN, G, c; size_t astep, bstep;
    __device__ __forceinline__ bool next(int i, Unit& u) const { return static_next(nM, nN, G, c, i, u); }
    __device__ __forceinline__ const char* a_base(const Unit& u) const { return A + (size_t)u.pm * astep; }
    __device__ __forceinline__ const char* b_base(const Unit& u) const { return Bt + (size_t)u.pn * bstep; }
    __device__ __forceinline__ unsigned row_off(const Unit&, int) const { return 0u; }
};
struct SchedSel {
    static constexpr bool HALF_SKIP = false;
    const char* A; const char* Bt; int nM, nSel, G, c; size_t astep, bstep; int fp8;
    __device__ __forceinline__ bool next(int i, Unit& u) const { if (!static_next(nM, nSel, G, c, i, u)) return false; u.e = u.pn;
        if (fp8) u.pn = TILES_FP8[u.e];
        else { int t = 0, k = -1; for (; t < 72; ++t) { bool in = false; for (int q = 0; q < N_FP8_TILES; ++q) in |= (TILES_FP8[q] == t); if (!in && ++k == u.e) break; } u.pn = t; }
        return true; }
    __device__ __forceinline__ const char* a_base(const Unit& u) const { return A + (size_t)u.pm * astep; }
    __device__ __forceinline__ const char* b_base(const Unit& u) const { return Bt + (size_t)(fp8 ? u.e : u.pn) * bstep; }
    __device__ __forceinline__ unsigned row_off(const Unit&, int) const { return 0u; }
};
struct SchedKV {
    static constexpr bool HALF_SKIP = false;
    const char* memb; const char* wkv; int G, c;
    __device__ __forceinline__ bool next(int i, Unit& u) const {
        const int L = i * G + c; if (L >= 32) return false;
        if (L < 16) { u.e = 0; u.pm = L & 1; u.pn = L >> 1; } else { const int l = L - 16; u.e = 1; u.pm = l >> 1; u.pn = l & 1; }
        u.mt = 0; u.rows = 256; u.idx = i; return true; }
    __device__ __forceinline__ const char* a_base(const Unit& u) const { return u.e == 0 ? memb + (size_t)u.pm * 256 * D * 2 : wkv + (size_t)(2048 + u.pm * 256) * D * 2; }
    __device__ __forceinline__ const char* b_base(const Unit& u) const { return u.e == 0 ? wkv + (size_t)u.pn * 256 * D * 2 : memb + (size_t)u.pn * 256 * D * 2; }
    __device__ __forceinline__ unsigned row_off(const Unit&, int) const { return 0u; }
};
struct SchedScores {
    static constexpr bool HALF_SKIP = false;
    const char* q; const char* kk; int G, c;
    __device__ __forceinline__ bool next(int i, Unit& u) const { return static_next(T / 256, XH, G, c, i, u); }
    __device__ __forceinline__ const char* a_base(const Unit& u) const { return q + ((size_t)u.pm * 256 * D + (size_t)u.pn * XDH) * 2; }
    __device__ __forceinline__ const char* b_base(const Unit& u) const { return kk + ((size_t)(u.pm / 32) * NMEM * D + (size_t)u.pn * XDH) * 2; }
    __device__ __forceinline__ unsigned row_off(const Unit&, int) const { return 0u; }
};
struct SchedPV {
    static constexpr bool HALF_SKIP = false;
    const char* P; const char* vt; int G, c;
    __device__ __forceinline__ bool next(int i, Unit& u) const { return static_next(T / 256, D / 256, G, c, i, u); }
    __device__ __forceinline__ const char* a_base(const Unit& u) const { return P + ((size_t)u.pm * 256 * 1024 + (size_t)(u.pn >> 1) * 256) * 2; }
    __device__ __forceinline__ const char* b_base(const Unit& u) const { return vt + ((size_t)u.pn * 256 * 512 + (size_t)(u.pm / 32) * NMEM) * 2; }
    __device__ __forceinline__ unsigned row_off(const Unit&, int) const { return 0u; }
};
template <class Base> struct SchedOwn : Base {
    int opm, opn0, on;
    __device__ __forceinline__ bool next(int i, Unit& u) const { if (i >= on) return false; u.pm = opm; u.pn = opn0 + i; u.e = 0; u.mt = 0; u.rows = 256; u.idx = i; return true; }
};
struct SchedMoe {
    static constexpr bool HALF_SKIP = true;
    const LAS int* tab; const char* A; const char* Bt; const int* list; int nN, G, c; size_t b_estride; int esz; const LAS unsigned short* toks;
    __device__ __forceinline__ int tb(int i) const { return __builtin_amdgcn_readfirstlane(tab[i]); }
    __device__ __forceinline__ bool next(int i, Unit& u) const {
        const int TM = tb(32), nwg = TM * nN; const long L = (long)i * G + c; if (L >= nwg) return false;
        int wgid = (int)L; { const int q = nwg / NXCD, r = nwg % NXCD, xcd = wgid % NXCD, off = wgid / NXCD; wgid = (xcd < r ? xcd * (q + 1) : r * (q + 1) + (xcd - r) * q) + off; }
        int lo = 0, hi = 31;
        while (lo < hi) { const int mid = (lo + hi) >> 1; if (wgid < tb(mid + 1) * nN) hi = mid; else lo = mid + 1; }
        const int e = lo, ts = tb(e), te = tb(e + 1) - ts, idx = wgid - ts * nN, cnt = tb(33 + e);
        u.e = e; u.pn = idx / te; u.mt = idx % te; u.pm = ts + u.mt; const int rem = cnt - u.mt * 256; u.rows = rem < 256 ? rem : 256; u.idx = i; return true; }
    __device__ __forceinline__ const char* a_base(const Unit& u) const { return A + (list ? (size_t)0 : (size_t)u.pm * 256 * D * esz); }
    __device__ __forceinline__ const char* b_base(const Unit& u) const { return Bt + (size_t)u.e * b_estride + (size_t)u.pn * 256 * D * esz; }
    __device__ __forceinline__ unsigned row_off(const Unit& u, int r) const {
        if (toks) return (unsigned)toks[u.idx * 256 + r] * (unsigned)(D * esz);
        int a = 0; if (r < u.rows) a = list[u.e * MOE_CAP + u.mt * 256 + r];
        return (unsigned)(a >> 2) * (unsigned)(D * esz); }
};

struct EpiBf16G {
    static constexpr bool PERM = true;
    bf16* O; int ldc; const float* bias; float scale; float ascale;
    __device__ __forceinline__ void operator()(const Acc& acc, const Unit& u, int wr, int wc, int fr, int fq) const {
        const int row0 = u.pm * BM + wr * 64 + fr, col0 = u.pn * BM + wc * 32 + 8 * fq;
        f32x4 bv[2][2];
#pragma unroll
        for (int bj = 0; bj < 2; ++bj)
#pragma unroll
            for (int n = 0; n < 2; ++n) bv[bj][n] = bias ? *(const f32x4*)(bias + col0 + bj * HALF + 4 * n) : (f32x4){0.f, 0.f, 0.f, 0.f};
#pragma unroll
        for (int ai = 0; ai < 2; ++ai)
#pragma unroll
            for (int m = 0; m < 4; ++m) { bf16* rowp = O + (size_t)(row0 + ai * HALF + m * 16) * ldc + col0;
#pragma unroll
                for (int bj = 0; bj < 2; ++bj) { f32x4 v0 = (acc[ai][bj][m][0] * ascale + bv[bj][0]) * scale, v1 = (acc[ai][bj][m][1] * ascale + bv[bj][1]) * scale;
                    v4u w; w.x = cvt_pk_bf16(v0[0], v0[1]); w.y = cvt_pk_bf16(v0[2], v0[3]); w.z = cvt_pk_bf16(v1[0], v1[1]); w.w = cvt_pk_bf16(v1[2], v1[3]);
                    *(v4u*)(rowp + bj * HALF) = w; } }
    }
};
struct EpiKV {
    static constexpr bool PERM = true;
    bf16* kk; bf16* vt;
    __device__ __forceinline__ void operator()(const Acc& acc, const Unit& u, int wr, int wc, int fr, int fq) const {
        bf16* O = u.e == 0 ? kk : vt; const int ldc = u.e == 0 ? D : 512;
        const int row0 = u.pm * BM + wr * 64 + fr, col0 = u.pn * BM + wc * 32 + 8 * fq;
#pragma unroll
        for (int ai = 0; ai < 2; ++ai)
#pragma unroll
            for (int m = 0; m < 4; ++m) { bf16* rowp = O + (size_t)(row0 + ai * HALF + m * 16) * ldc + col0;
#pragma unroll
                for (int bj = 0; bj < 2; ++bj) { const f32x4 v0 = acc[ai][bj][m][0], v1 = acc[ai][bj][m][1];
                    v4u w; w.x = cvt_pk_bf16(v0[0], v0[1]); w.y = cvt_pk_bf16(v0[2], v0[3]); w.z = cvt_pk_bf16(v1[0], v1[1]); w.w = cvt_pk_bf16(v1[2], v1[3]);
                    *(v4u*)(rowp + bj * HALF) = w; } }
    }
};
struct EpiF32Res {
    static constexpr bool PERM = false;
    float* C; int ldc; const float* res; float rs;
    __device__ __forceinline__ void operator()(const Acc& acc, const Unit& u, int wr, int wc, int fr, int fq) const {
        const int row0 = u.pm * BM + wr * 64 + fr, col0 = u.pn * BM + wc * 32 + 4 * fq;
#pragma unroll
        for (int ai = 0; ai < 2; ++ai)
#pragma unroll
            for (int m = 0; m < 4; ++m) { const size_t ro = (size_t)(row0 + ai * HALF + m * 16) * ldc + col0;
#pragma unroll
                for (int bj = 0; bj < 2; ++bj)
#pragma unroll
                    for (int n = 0; n < 2; ++n) { f32x4 v = acc[ai][bj][m][n]; if (res) v = v + rs * *(const f32x4*)(res + ro + bj * HALF + n * 16); *(f32x4*)(C + ro + bj * HALF + n * 16) = v; } }
    }
};
struct EpiFp8 {
    static constexpr bool PERM = true;
    unsigned char* O; int ldc; float scale;
    __device__ __forceinline__ void operator()(const Acc& acc, const Unit& u, int wr, int wc, int fr, int fq) const {
        const int row0 = u.pm * BM + wr * 64 + fr, col0 = u.pn * BM + wc * 32 + 8 * fq;
#pragma unroll
        for (int ai = 0; ai < 2; ++ai)
#pragma unroll
            for (int m = 0; m < 4; ++m) { unsigned char* rowp = O + (size_t)(row0 + ai * HALF + m * 16) * ldc + col0;
#pragma unroll
                for (int bj = 0; bj < 2; ++bj) { const f32x4 v0 = acc[ai][bj][m][0] * scale, v1 = acc[ai][bj][m][1] * scale; v2u w;
                    { unsigned t = 0u; t = __builtin_amdgcn_cvt_pk_fp8_f32(v0[0], v0[1], t, false); t = __builtin_amdgcn_cvt_pk_fp8_f32(v0[2], v0[3], t, true); w.x = t; t = 0u; t = __builtin_amdgcn_cvt_pk_fp8_f32(v1[0], v1[1], t, false); t = __builtin_amdgcn_cvt_pk_fp8_f32(v1[2], v1[3], t, true); w.y = t; }
                    *(v2u*)(rowp + bj * HALF) = w; } }
    }
};
struct EpiBf16Res {
    static constexpr bool PERM = true;
    bf16* O; int ldc; const float* resf; const bf16* resb; float rs; float ascale;
    __device__ __forceinline__ void operator()(const Acc& acc, const Unit& u, int wr, int wc, int fr, int fq) const {
        const int row0 = u.pm * BM + wr * 64 + fr, col0 = u.pn * BM + wc * 32 + 8 * fq;
#pragma unroll
        for (int ai = 0; ai < 2; ++ai)
#pragma unroll
            for (int m = 0; m < 4; ++m) { const size_t ro = (size_t)(row0 + ai * HALF + m * 16) * ldc + col0;
#pragma unroll
                for (int bj = 0; bj < 2; ++bj) { f32x4 r0, r1;
                    if (resf) { r0 = *(const f32x4*)(resf + ro + bj * HALF); r1 = *(const f32x4*)(resf + ro + bj * HALF + 4); }
                    else { const v4u w = *(const v4u*)(resb + ro + bj * HALF); r0 = (f32x4){__uint_as_float(w.x << 16), __uint_as_float(w.x & 0xffff0000u), __uint_as_float(w.y << 16), __uint_as_float(w.y & 0xffff0000u)};
                        r1 = (f32x4){__uint_as_float(w.z << 16), __uint_as_float(w.z & 0xffff0000u), __uint_as_float(w.w << 16), __uint_as_float(w.w & 0xffff0000u)}; }
                    const f32x4 v0 = acc[ai][bj][m][0] * ascale + rs * r0, v1 = acc[ai][bj][m][1] * ascale + rs * r1;
                    v4u w; w.x = cvt_pk_bf16(v0[0], v0[1]); w.y = cvt_pk_bf16(v0[2], v0[3]); w.z = cvt_pk_bf16(v1[0], v1[1]); w.w = cvt_pk_bf16(v1[2], v1[3]);
                    *(v4u*)(O + ro + bj * HALF) = w; } }
    }
};
struct EpiPre1 {
    static constexpr bool PERM = true;
    bf16* O; unsigned char* O8; int ldc; const float* resf; float rs; float* stats;
    __device__ __forceinline__ void operator()(const Acc& acc, const Unit& u, int wr, int wc, int fr, int fq) const {
        const int row0 = u.pm * BM + wr * 64 + fr, col0 = u.pn * BM + wc * 32 + 8 * fq;
#pragma unroll
        for (int ai = 0; ai < 2; ++ai)
#pragma unroll
            for (int m = 0; m < 4; ++m) { const int row = row0 + ai * HALF + m * 16; const size_t ro = (size_t)row * ldc + col0; float s1 = 0.f, s2 = 0.f;
#pragma unroll
                for (int bj = 0; bj < 2; ++bj) { const f32x4 r0 = *(const f32x4*)(resf + ro + bj * HALF), r1 = *(const f32x4*)(resf + ro + bj * HALF + 4);
                    const f32x4 v0 = acc[ai][bj][m][0] + rs * r0, v1 = acc[ai][bj][m][1] + rs * r1;
                    s1 += ((v0[0] + v0[1]) + (v0[2] + v0[3])) + ((v1[0] + v1[1]) + (v1[2] + v1[3]));
                    s2 += ((v0[0] * v0[0] + v0[1] * v0[1]) + (v0[2] * v0[2] + v0[3] * v0[3])) + ((v1[0] * v1[0] + v1[1] * v1[1]) + (v1[2] * v1[2] + v1[3] * v1[3]));
                    v4u w; w.x = cvt_pk_bf16(v0[0], v0[1]); w.y = cvt_pk_bf16(v0[2], v0[3]); w.z = cvt_pk_bf16(v1[0], v1[1]); w.w = cvt_pk_bf16(v1[2], v1[3]);
                    *(v4u*)(O + ro + bj * HALF) = w;
                    v2u w8; { unsigned t = 0u; t = __builtin_amdgcn_cvt_pk_fp8_f32(v0[0], v0[1], t, false); t = __builtin_amdgcn_cvt_pk_fp8_f32(v0[2], v0[3], t, true); w8.x = t; t = 0u; t = __builtin_amdgcn_cvt_pk_fp8_f32(v1[0], v1[1], t, false); t = __builtin_amdgcn_cvt_pk_fp8_f32(v1[2], v1[3], t, true); w8.y = t; }
                    *(v2u*)(O8 + ro + bj * HALF) = w8; }
                s1 += __shfl_xor(s1, 16); s1 += __shfl_xor(s1, 32); s2 += __shfl_xor(s2, 16); s2 += __shfl_xor(s2, 32);
                if (fq == 0) *(f32x2*)(stats + ((size_t)row * 32 + u.pn * 4 + wc) * 2) = (f32x2){s1, s2}; }
    }
};
struct EpiQFold {
    static constexpr bool PERM = true;
    bf16* O; int ldc; const float* stats; const float* c1; const float* c2; float scale; float ascale;
    __device__ __forceinline__ void operator()(const Acc& acc, const Unit& u, int wr, int wc, int fr, int fq) const {
        const int row0 = u.pm * BM + wr * 64 + fr, col0 = u.pn * BM + wc * 32 + 8 * fq;
#pragma unroll
        for (int bj = 0; bj < 2; ++bj) {
            const f32x4 a10 = *(const f32x4*)(c1 + col0 + bj * HALF), a11 = *(const f32x4*)(c1 + col0 + bj * HALF + 4), a20 = *(const f32x4*)(c2 + col0 + bj * HALF), a21 = *(const f32x4*)(c2 + col0 + bj * HALF + 4);
#pragma unroll
            for (int ai = 0; ai < 2; ++ai)
#pragma unroll
                for (int m = 0; m < 4; ++m) { const int row = row0 + ai * HALF + m * 16; const f32x2 st = *(const f32x2*)(stats + 2 * (size_t)row); const float mu = st[0], rstd = st[1];
                    const f32x4 v0 = ((acc[ai][bj][m][0] * ascale - mu * a10) * rstd + a20) * scale, v1 = ((acc[ai][bj][m][1] * ascale - mu * a11) * rstd + a21) * scale;
                    v4u w; w.x = cvt_pk_bf16(v0[0], v0[1]); w.y = cvt_pk_bf16(v0[2], v0[3]); w.z = cvt_pk_bf16(v1[0], v1[1]); w.w = cvt_pk_bf16(v1[2], v1[3]);
                    *(v4u*)(O + (size_t)row * ldc + col0 + bj * HALF) = w; } }
    }
};
struct EpiXoFold {
    static constexpr bool PERM = true;
    bf16* O; int ldc; const bf16* pre; const float* stats; const float* g; const float* b; float rs; float ascale;
    __device__ __forceinline__ void operator()(const Acc& acc, const Unit& u, int wr, int wc, int fr, int fq) const {
        const int row0 = u.pm * BM + wr * 64 + fr, col0 = u.pn * BM + wc * 32 + 8 * fq;
#pragma unroll
        for (int bj = 0; bj < 2; ++bj) {
            const f32x4 g0 = *(const f32x4*)(g + col0 + bj * HALF), g1 = *(const f32x4*)(g + col0 + bj * HALF + 4), b0 = *(const f32x4*)(b + col0 + bj * HALF), b1 = *(const f32x4*)(b + col0 + bj * HALF + 4);
#pragma unroll
            for (int ai = 0; ai < 2; ++ai)
#pragma unroll
                for (int m = 0; m < 4; ++m) { const int row = row0 + ai * HALF + m * 16; const size_t ro = (size_t)row * ldc + col0 + bj * HALF; const f32x2 st = *(const f32x2*)(stats + 2 * (size_t)row); const float mu = st[0], rstd = st[1];
                    const v4u pw = *(const v4u*)(pre + ro);
                    const f32x4 p0 = (f32x4){__uint_as_float(pw.x << 16), __uint_as_float(pw.x & 0xffff0000u), __uint_as_float(pw.y << 16), __uint_as_float(pw.y & 0xffff0000u)};
                    const f32x4 p1 = (f32x4){__uint_as_float(pw.z << 16), __uint_as_float(pw.z & 0xffff0000u), __uint_as_float(pw.w << 16), __uint_as_float(pw.w & 0xffff0000u)};
                    const f32x4 h0 = (p0 - mu) * rstd * g0 + b0, h1_ = (p1 - mu) * rstd * g1 + b1;
                    const f32x4 v0 = acc[ai][bj][m][0] * ascale + rs * h0, v1 = acc[ai][bj][m][1] * ascale + rs * h1_;
                    v4u w; w.x = cvt_pk_bf16(v0[0], v0[1]); w.y = cvt_pk_bf16(v0[2], v0[3]); w.z = cvt_pk_bf16(v1[0], v1[1]); w.w = cvt_pk_bf16(v1[2], v1[3]);
                    *(v4u*)(O + ro) = w; } }
    }
};
struct EpiSoftmax {
    static constexpr bool PERM = true;
    bf16* P; int ldc; LAS float* red;
    __device__ __forceinline__ void operator()(Acc& acc, const Unit& u, int wr, int wc, int fr, int fq) const {
        LAS float* RM = red + wr * 512; LAS float* RS = red + 1024 + wr * 512;
#pragma unroll
        for (int ai = 0; ai < 2; ++ai)
#pragma unroll
            for (int m = 0; m < 4; ++m) { float mx = -3.0e38f;
#pragma unroll
                for (int bj = 0; bj < 2; ++bj)
#pragma unroll
                    for (int n = 0; n < 2; ++n) { const f32x4 v = acc[ai][bj][m][n]; mx = fmaxf(mx, fmaxf(fmaxf(v[0], v[1]), fmaxf(v[2], v[3]))); }
                mx = fmaxf(mx, __shfl_xor(mx, 16)); mx = fmaxf(mx, __shfl_xor(mx, 32));
                if (fq == 0) RM[(ai * 64 + m * 16 + fr) * 4 + wc] = mx; }
        asm volatile("s_waitcnt lgkmcnt(0)" ::: "memory"); __builtin_amdgcn_s_barrier(); asm volatile("" ::: "memory");
#pragma unroll
        for (int ai = 0; ai < 2; ++ai)
#pragma unroll
            for (int m = 0; m < 4; ++m) { const f32x4 pm = *(const LAS f32x4*)(RM + (ai * 64 + m * 16 + fr) * 4); const float mx = fmaxf(fmaxf(pm[0], pm[1]), fmaxf(pm[2], pm[3])); float sm = 0.f;
#pragma unroll
                for (int bj = 0; bj < 2; ++bj)
#pragma unroll
                    for (int n = 0; n < 2; ++n) { f32x4 v = acc[ai][bj][m][n]; v[0] = __expf(v[0] - mx); v[1] = __expf(v[1] - mx); v[2] = __expf(v[2] - mx); v[3] = __expf(v[3] - mx); acc[ai][bj][m][n] = v; sm += (v[0] + v[1]) + (v[2] + v[3]); }
                sm += __shfl_xor(sm, 16); sm += __shfl_xor(sm, 32);
                if (fq == 0) RS[(ai * 64 + m * 16 + fr) * 4 + wc] = sm; }
        asm volatile("s_waitcnt lgkmcnt(0)" ::: "memory"); __builtin_amdgcn_s_barrier(); asm volatile("" ::: "memory");
        const int row0 = u.pm * BM + wr * 64 + fr, col0 = u.pn * BM + wc * 32 + 8 * fq;
#pragma unroll
        for (int ai = 0; ai < 2; ++ai)
#pragma unroll
            for (int m = 0; m < 4; ++m) { const f32x4 ps = *(const LAS f32x4*)(RS + (ai * 64 + m * 16 + fr) * 4); const float inv = __builtin_amdgcn_rcpf((ps[0] + ps[1]) + (ps[2] + ps[3]));
                bf16* rowp = P + (size_t)(row0 + ai * HALF + m * 16) * ldc + col0;
#pragma unroll
                for (int bj = 0; bj < 2; ++bj) { const f32x4 v0 = acc[ai][bj][m][0] * inv, v1 = acc[ai][bj][m][1] * inv;
                    v4u w; w.x = cvt_pk_bf16(v0[0], v0[1]); w.y = cvt_pk_bf16(v0[2], v0[3]); w.z = cvt_pk_bf16(v1[0], v1[1]); w.w = cvt_pk_bf16(v1[2], v1[3]);
                    *(v4u*)(rowp + bj * HALF) = w; } }
        asm volatile("s_waitcnt lgkmcnt(0)" ::: "memory"); __builtin_amdgcn_s_barrier(); asm volatile("" ::: "memory");
    }
};
struct EpiSwiglu {
    static constexpr bool PERM = true;
    bf16* act; const float* bias; float ws;
    __device__ __forceinline__ void operator()(const Acc& acc, const Unit& u, int wr, int wc, int fr, int fq) const {
        const int row0 = u.pm * BM + wr * 64 + fr, cc = wc * 32 + 8 * fq; const float* bp = bias + (size_t)u.e * 4096 + u.pn * BM + cc;
        f32x4 bv[2][2];
#pragma unroll
        for (int bj = 0; bj < 2; ++bj)
#pragma unroll
            for (int n = 0; n < 2; ++n) bv[bj][n] = *(const f32x4*)(bp + bj * HALF + 4 * n);
#pragma unroll
        for (int ai = 0; ai < 2; ++ai)
#pragma unroll
            for (int m = 0; m < 4; ++m) { unsigned char* rowp = (unsigned char*)act + (size_t)(row0 + ai * HALF + m * 16) * D + u.pn * HALF + cc;
                float o[8];
#pragma unroll
                for (int n = 0; n < 2; ++n) { const f32x4 g = acc[ai][0][m][n] * ws + bv[0][n], l = acc[ai][1][m][n] * ws + bv[1][n];
#pragma unroll
                    for (int k = 0; k < 4; ++k) { const float gl = fminf(g[k], 7.0f), li = fminf(fmaxf(l[k], -7.0f), 7.0f); o[n * 4 + k] = gl * sigmoidf_(1.702f * gl) * (li + 1.0f); } }
                v2u w; { unsigned t = 0u; t = __builtin_amdgcn_cvt_pk_fp8_f32(o[0], o[1], t, false); t = __builtin_amdgcn_cvt_pk_fp8_f32(o[2], o[3], t, true); w.x = t; t = 0u; t = __builtin_amdgcn_cvt_pk_fp8_f32(o[4], o[5], t, false); t = __builtin_amdgcn_cvt_pk_fp8_f32(o[6], o[7], t, true); w.y = t; }
                *(v2u*)rowp = w; }
    }
};
struct EpiDown {
    static constexpr bool PERM = true;
    bf16* ybuf; const float* bias; const int* list; const float* gates; float ws; const LAS int* tA; const LAS float* tG;
    __device__ __forceinline__ void operator()(const Acc& acc, const Unit& u, int wr, int wc, int fr, int fq) const {
        const int r0 = wr * 64 + fr, col0 = u.pn * BM + wc * 32 + 8 * fq; const float* bp = bias + (size_t)u.e * D + col0;
        f32x4 bv[2][2];
#pragma unroll
        for (int bj = 0; bj < 2; ++bj)
#pragma unroll
            for (int n = 0; n < 2; ++n) bv[bj][n] = *(const f32x4*)(bp + bj * HALF + 4 * n);
#pragma unroll
        for (int ai = 0; ai < 2; ++ai)
#pragma unroll
            for (int m = 0; m < 4; ++m) { const int r = r0 + ai * HALF + m * 16;
                int a; float g;
                if (tA) { a = tA[u.idx * 256 + r]; g = tG[u.idx * 256 + r]; } else if (r < u.rows) { a = list[u.e * MOE_CAP + u.mt * 256 + r]; g = gates[a]; } else { a = -1; g = 0.f; }
                if (a >= 0) { unsigned char* rowp = (unsigned char*)ybuf + (size_t)a * D + col0; const float g16 = g * 16.0f;
#pragma unroll
                    for (int bj = 0; bj < 2; ++bj) { const f32x4 v0 = (acc[ai][bj][m][0] * ws + bv[bj][0]) * g16, v1 = (acc[ai][bj][m][1] * ws + bv[bj][1]) * g16; v2u w;
                        { unsigned t = 0u; t = __builtin_amdgcn_cvt_pk_fp8_f32(v0[0], v0[1], t, false); t = __builtin_amdgcn_cvt_pk_fp8_f32(v0[2], v0[3], t, true); w.x = t; t = 0u; t = __builtin_amdgcn_cvt_pk_fp8_f32(v1[0], v1[1], t, false); t = __builtin_amdgcn_cvt_pk_fp8_f32(v1[2], v1[3], t, true); w.y = t; }
                        *(v2u*)(rowp + bj * HALF) = w; } } }
    }
};
}

#define XB_TMO      128
#define XB_XCNT(j)  (256  + 64 * (j))
#define XB_XSUB(j)  (1280 + 64 * (j))
#define XB_XGEN(j)  (2304 + 64 * (j))
#define XB_TOP      3328
#define XB_TOPGEN   3392
#define XCD_BAR_WORDS 3456
#define XB_SPIN_CAP (1u << 20)
__device__ __forceinline__ unsigned xb_ld(unsigned* p)              { return __hip_atomic_load(p, __ATOMIC_RELAXED, __HIP_MEMORY_SCOPE_AGENT); }
__device__ __forceinline__ unsigned xb_add(unsigned* p, unsigned v) { return __hip_atomic_fetch_add(p, v, __ATOMIC_RELAXED, __HIP_MEMORY_SCOPE_AGENT); }
__device__ __forceinline__ unsigned xb_xcc_id() { return (unsigned)__builtin_amdgcn_s_getreg((3 << 11) | 20) & 0xFu; }
#define XB_SPIN(cond, bar) do { unsigned _sp = 0; while (cond) { __builtin_amdgcn_s_sleep(1); \
    if ((++_sp & 255u) == 0u) { if (xb_ld(&(bar)[XB_TMO])) break; if (_sp > XB_SPIN_CAP) { atomicAdd(&(bar)[XB_TMO], 1u); break; } } } } while (0)
struct XcdBarrier { unsigned* bar; unsigned x; volatile LAS unsigned* st; };
__device__ __forceinline__ XcdBarrier xcd_barrier_post(unsigned* bar, volatile LAS unsigned* st) {
    XcdBarrier b; b.bar = bar; b.x = xb_xcc_id(); b.st = st;
    if (threadIdx.x == 0) (void)xb_add(&bar[XB_XCNT(b.x)], 1u);
    return b;
}
__device__ __forceinline__ void xcd_barrier_complete(unsigned* bar, unsigned x, unsigned& nloc, unsigned& nx) {
    const unsigned G = gridDim.x * gridDim.y * gridDim.z;
    unsigned sum, cnt, mine, sp = 0u;
    for (;;) {
        sum = 0u; cnt = 0u; mine = 0u;
#pragma unroll
        for (unsigned j = 0; j < 16; ++j) { const unsigned c = xb_ld(&bar[XB_XCNT(j)]); sum += c; cnt += (c > 0u) ? 1u : 0u; mine = (j == x) ? c : mine; }
        if (sum == G) break;
        __builtin_amdgcn_s_sleep(1);
        if ((++sp & 255u) == 0u) { if (xb_ld(&bar[XB_TMO])) break; if (sp > XB_SPIN_CAP) { atomicAdd(&bar[XB_TMO], 1u); break; } }
    }
    nloc = mine > 0u ? mine : 1u; nx = cnt > 0u ? cnt : 1u;
}
__device__ __forceinline__ void xcd_barrier(const XcdBarrier& b) {
    asm volatile("s_waitcnt vmcnt(0)" ::: "memory");
    __syncthreads();
    if (threadIdx.x == 0) {
        unsigned* bar = b.bar;
        __builtin_amdgcn_s_waitcnt(0);
        unsigned nloc = b.st[0], nx = b.st[1];
        if (nloc == 0u) { xcd_barrier_complete(bar, b.x, nloc, nx); b.st[0] = nloc; b.st[1] = nx; }
        const unsigned old = xb_add(&bar[XB_XSUB(b.x)], 1u);
        const unsigned gen = old / nloc;
        if (old + 1u == (gen + 1u) * nloc) {
            __builtin_amdgcn_fence(__ATOMIC_RELEASE, "agent");
            asm volatile("s_waitcnt vmcnt(0)" ::: "memory");
            const unsigned og = xb_add(&bar[XB_TOP], 1u);
            const unsigned tg = og / nx;
            if (og + 1u == (tg + 1u) * nx) xb_add(&bar[XB_TOPGEN], 1u);
            else XB_SPIN(xb_ld(&bar[XB_TOPGEN]) == tg, bar);
            __builtin_amdgcn_fence(__ATOMIC_ACQUIRE, "agent");
            xb_add(&bar[XB_XGEN(b.x)], 1u);
            asm volatile("s_waitcnt vmcnt(0)" ::: "memory");
        } else {
            XB_SPIN(xb_ld(&bar[XB_XGEN(b.x)]) == gen, bar);
            __builtin_amdgcn_fence(__ATOMIC_ACQUIRE, "agent");
            asm volatile("s_waitcnt vmcnt(0)" ::: "memory");
        }
    }
    __syncthreads();
}

__device__ __forceinline__ int tmap(int mode, int n) {
    if (mode == 0) return n;
    if (mode == 1) return n < GA1_COL ? n : (n < GA1_COL + 16 ? -1 : n - 16);
    const int j = n >> 1, par = n & 1; return 256 * (j >> 7) + 128 * par + (j & 127);
}
__device__ __forceinline__ void transpose_item(const float* W, int N, int Nout, int mode, bf16* WT, int item, int nnb, int lane) {
    const int nb = item % nnb, kbg = item / nnb, e = kbg >> 5, k0 = (kbg & 31) * 64, n0 = nb * 64;
    const int kq = lane & 7, nq = lane >> 3;
    const float* src = W + ((size_t)e * D + k0 + 8 * kq) * N + n0 + 4 * nq;
    f32x4 v[2][8]; bool inb[2];
#pragma unroll
    for (int g = 0; g < 2; ++g) { inb[g] = (n0 + 32 * g + 4 * nq) < N;
#pragma unroll
        for (int j = 0; j < 8; ++j) v[g][j] = inb[g] ? *(const f32x4*)(src + (size_t)j * N + 32 * g) : (f32x4){0.f, 0.f, 0.f, 0.f}; }
#pragma unroll
    for (int g = 0; g < 2; ++g)
#pragma unroll
        for (int c = 0; c < 4; ++c) { const int n = n0 + 32 * g + 4 * nq + c; const int dr = inb[g] ? tmap(mode, n) : -1;
            if (dr >= 0) { v4u w; w.x = pk2(v[g][0][c], v[g][1][c]); w.y = pk2(v[g][2][c], v[g][3][c]); w.z = pk2(v[g][4][c], v[g][5][c]); w.w = pk2(v[g][6][c], v[g][7][c]);
                *(v4u*)(WT + ((size_t)e * Nout + dr) * D + k0 + 8 * kq) = w; } }
}

__device__ __forceinline__ unsigned pk4_fp8(float a, float b, float c, float d) { unsigned w = 0u; w = __builtin_amdgcn_cvt_pk_fp8_f32(a, b, w, false); w = __builtin_amdgcn_cvt_pk_fp8_f32(c, d, w, true); return w; }
__device__ __forceinline__ void transpose_item_fp8(const float* W, int N, int Nout, int mode, unsigned char* WT, int item, int nnb, int lane, float scale, const float* rowscale = nullptr) {
    const int nb = item % nnb, kbg = item / nnb, e = kbg >> 4, k0 = (kbg & 15) * 128, n0 = nb * 32;
    const int kq = lane & 7, nq = lane >> 3;
    const int nv = n0 + 4 * nq; int ns = nv; if (mode == 3) { const int np = TILES_FP8[nv >> 8] * 256 + (nv & 255); ns = np < GA1_COL ? np : np + 16; }
    const float* src = W + ((size_t)e * D + k0 + 16 * kq) * N + ns;
    f32x4 v[16];
#pragma unroll
    for (int j = 0; j < 16; ++j) v[j] = __builtin_nontemporal_load((const f32x4*)(src + (size_t)j * N)) * (rowscale ? scale * rowscale[k0 + 16 * kq + j] : scale);
#pragma unroll
    for (int c = 0; c < 4; ++c) { const int dr = mode == 3 ? nv + c : tmap(mode, nv + c);
        v4u w; w.x = pk4_fp8(v[0][c], v[1][c], v[2][c], v[3][c]); w.y = pk4_fp8(v[4][c], v[5][c], v[6][c], v[7][c]); w.z = pk4_fp8(v[8][c], v[9][c], v[10][c], v[11][c]); w.w = pk4_fp8(v[12][c], v[13][c], v[14][c], v[15][c]);
        __builtin_nontemporal_store(w, (v4u*)(WT + ((size_t)e * Nout + dr) * D + k0 + 16 * kq)); }
}

__device__ __forceinline__ void ln1_finish(const float* stats, float* fst, int row) {
    const f32x4* p = (const f32x4*)(stats + (size_t)row * 64); float s1 = 0.f, s2 = 0.f;
#pragma unroll
    for (int i = 0; i < 16; ++i) { const f32x4 v = p[i]; s1 += v[0] + v[2]; s2 += v[1] + v[3]; }
    const float mu = s1 * (1.0f / D), rstd = __builtin_amdgcn_rsqf(s2 * (1.0f / D) - mu * mu + EPS);
    *(f32x2*)(fst + 2 * (size_t)row) = (f32x2){mu, rstd};
}
__device__ __forceinline__ void ln_apply(f32x4 (&v)[8], const float* g, const float* b, int lane) {
    float s = 0.f;
#pragma unroll
    for (int j = 0; j < 8; ++j) s += (v[j][0] + v[j][1]) + (v[j][2] + v[j][3]);
    const float mean = wave_sum(s) * (1.0f / D); float s2 = 0.f;
#pragma unroll
    for (int j = 0; j < 8; ++j) { v[j] = v[j] - mean; s2 += (v[j][0] * v[j][0] + v[j][1] * v[j][1]) + (v[j][2] * v[j][2] + v[j][3] * v[j][3]); }
    const float rstd = __builtin_amdgcn_rsqf(wave_sum(s2) * (1.0f / D) + EPS);
#pragma unroll
    for (int j = 0; j < 8; ++j) { const f32x4 gg = *(const f32x4*)(g + 4 * lane + 256 * j), bb = *(const f32x4*)(b + 4 * lane + 256 * j); v[j] = v[j] * rstd * gg + bb; }
}
#define COLB(j) (8 * lane + 512 * ((j) >> 1) + 4 * ((j) & 1))
__device__ __forceinline__ void ln_apply_b(f32x4 (&v)[8], const float* g, const float* b, int lane) {
    float s = 0.f;
#pragma unroll
    for (int j = 0; j < 8; ++j) s += (v[j][0] + v[j][1]) + (v[j][2] + v[j][3]);
    const float mean = wave_sum(s) * (1.0f / D); float s2 = 0.f;
#pragma unroll
    for (int j = 0; j < 8; ++j) { v[j] = v[j] - mean; s2 += (v[j][0] * v[j][0] + v[j][1] * v[j][1]) + (v[j][2] * v[j][2] + v[j][3] * v[j][3]); }
    const float rstd = __builtin_amdgcn_rsqf(wave_sum(s2) * (1.0f / D) + EPS);
#pragma unroll
    for (int j = 0; j < 8; ++j) { const f32x4 gg = *(const f32x4*)(g + COLB(j)), bb = *(const f32x4*)(b + COLB(j)); v[j] = v[j] * rstd * gg + bb; }
}
__device__ __forceinline__ void ln_apply_b_st(f32x4 (&v)[8], const float* g, const float* b, int lane, float& mean_o, float& rstd_o) {
    float s = 0.f;
#pragma unroll
    for (int j = 0; j < 8; ++j) s += (v[j][0] + v[j][1]) + (v[j][2] + v[j][3]);
    const float mean = wave_sum(s) * (1.0f / D); float s2 = 0.f;
#pragma unroll
    for (int j = 0; j < 8; ++j) { v[j] = v[j] - mean; s2 += (v[j][0] * v[j][0] + v[j][1] * v[j][1]) + (v[j][2] * v[j][2] + v[j][3] * v[j][3]); }
    const float rstd = __builtin_amdgcn_rsqf(wave_sum(s2) * (1.0f / D) + EPS);
#pragma unroll
    for (int j = 0; j < 8; ++j) { const f32x4 gg = *(const f32x4*)(g + COLB(j)), bb = *(const f32x4*)(b + COLB(j)); v[j] = v[j] * rstd * gg + bb; }
    mean_o = mean; rstd_o = rstd;
}
__device__ __forceinline__ void bf16x8_to_f32(const v4u w, f32x4& a, f32x4& b) {
    a = (f32x4){__uint_as_float(w.x << 16), __uint_as_float(w.x & 0xffff0000u), __uint_as_float(w.y << 16), __uint_as_float(w.y & 0xffff0000u)};
    b = (f32x4){__uint_as_float(w.z << 16), __uint_as_float(w.z & 0xffff0000u), __uint_as_float(w.w << 16), __uint_as_float(w.w & 0xffff0000u)}; }
__device__ __forceinline__ void row_load_bf16_b(const bf16* p, f32x4 (&v)[8], int lane) {
#pragma unroll
    for (int j2 = 0; j2 < 4; ++j2) bf16x8_to_f32(*(const v4u*)(p + 8 * lane + 512 * j2), v[2 * j2], v[2 * j2 + 1]);
}
__device__ __forceinline__ void row_store_bf16_b(bf16* o, const f32x4 (&v)[8], int lane) {
#pragma unroll
    for (int j2 = 0; j2 < 4; ++j2) { v4u w; w.x = pk2(v[2 * j2][0], v[2 * j2][1]); w.y = pk2(v[2 * j2][2], v[2 * j2][3]); w.z = pk2(v[2 * j2 + 1][0], v[2 * j2 + 1][1]); w.w = pk2(v[2 * j2 + 1][2], v[2 * j2 + 1][3]); *(v4u*)(o + 8 * lane + 512 * j2) = w; }
}
__device__ __forceinline__ void row_store_f32_b(float* o, const f32x4 (&v)[8], int lane) {
#pragma unroll
    for (int j = 0; j < 8; ++j) *(f32x4*)(o + COLB(j)) = v[j];
}
__device__ __forceinline__ void row_store_f32(float* o, const f32x4 (&v)[8], int lane) {
#pragma unroll
    for (int j = 0; j < 8; ++j) *(f32x4*)(o + 4 * lane + 256 * j) = v[j];
}
__device__ __forceinline__ void row_store_bf16(bf16* o, const f32x4 (&v)[8], int lane) {
#pragma unroll
    for (int j = 0; j < 8; ++j) { v2u w; w.x = pk2(v[j][0], v[j][1]); w.y = pk2(v[j][2], v[j][3]); *(v2u*)(o + 4 * lane + 256 * j) = w; }
}
__device__ __forceinline__ f32x4 ld_bf16x4(const bf16* p) { const v2u w = *(const v2u*)p; return (f32x4){bf2f(w.x & 0xffffu), bf2f(w.x >> 16), bf2f(w.y & 0xffffu), bf2f(w.y >> 16)}; }


typedef float f32x16 __attribute__((ext_vector_type(16)));
typedef short s16x4_t __attribute__((ext_vector_type(4)));
typedef __bf16 bf16x2_t __attribute__((ext_vector_type(2)));
__device__ __forceinline__ unsigned cvtpk(float lo, float hi) { f32x2 v = {lo, hi}; bf16x2_t b = __builtin_convertvector(v, bf16x2_t); return __builtin_bit_cast(unsigned, b); }
__device__ __forceinline__ int crow(int reg, int hh) { return (reg & 3) + 8 * (reg >> 2) + 4 * hh; }
__device__ __forceinline__ v4u piece16(const float (&v)[16], int hh2) {
    v4u w; if (hh2 == 0) { w.x = cvtpk(v[0], v[1]); w.y = cvtpk(v[2], v[3]); w.z = cvtpk(v[8], v[9]); w.w = cvtpk(v[10], v[11]); }
    else { w.x = cvtpk(v[4], v[5]); w.y = cvtpk(v[6], v[7]); w.z = cvtpk(v[12], v[13]); w.w = cvtpk(v[14], v[15]); }
    return w; }
constexpr int PP_GS = 0, PP_KS = 33792, PP_QI = 67584, PP_KH = 83968, PP_KI = 100352, PP_SEG = 116736, PP_GT = PP_SEG + 2048;

struct PrepIn { unsigned short kin[16]; v4u q0, q1; };
template <int KIND>
__device__ __forceinline__ void prep_load(PrepIn& R, int tid, int wave, const bf16* proj_, int b, int h, int c, int sl) {
    constexpr int DK = KIND == 0 ? 256 : 128; constexpr int QCOL = KIND == 0 ? GQ : HQ, KCOL = KIND == 0 ? GK : HF;
    const size_t tok0 = (size_t)b * SEQ + (size_t)c * 64; const int d = tid & 127, seg = wave >> 1, d0 = 128 * sl;
#pragma unroll
    for (int t = 0; t < 16; ++t) R.kin[t] = proj_[(tok0 + seg * 16 + t) * NPROJ + KCOL + h * DK + d0 + d];
    const bf16* qp = proj_ + (tok0 + (tid >> 3)) * NPROJ + QCOL + h * DK + d0 + 16 * (tid & 7);
    R.q0 = *(const v4u*)qp; R.q1 = *(const v4u*)(qp + 8);
}
template <int KIND>
__device__ __forceinline__ void prep_unit(LAS unsigned char* lds, int tid, int b, int h, int c, int nb_, int nh_, int nc_, bool has_next, PrepIn& cur, const bf16* proj_, const float* ga1_, const float* w_a2_, const float* b_a_, const float* lbt_,
                                          unsigned char* QF, unsigned char* KF, unsigned char* PF, float* LAM, unsigned char* VF) {
    constexpr int DK = KIND == 0 ? 256 : 128, DV = KIND == 0 ? 512 : 128, NSLAB = DK / 128, NEB = DV / 128;
    constexpr int QCOL = KIND == 0 ? GQ : HQ, KCOL = KIND == 0 ? GK : HF, VCOL = KIND == 0 ? GV : HI;
    const int lane = tid & 63, wave = __builtin_amdgcn_readfirstlane(tid >> 6), r = lane & 31, hh = lane >> 5;
    const size_t tok0 = (size_t)b * SEQ + (size_t)c * 64;
    LAS float* Gs = (LAS float*)(lds + PP_GS); LAS float* Ks = (LAS float*)(lds + PP_KS); LAS float* SEGT = (LAS float*)(lds + PP_SEG); LAS float* GT = (LAS float*)(lds + PP_GT);
    LAS unsigned char* QI = lds + PP_QI; LAS unsigned char* KH = lds + PP_KH; LAS unsigned char* KI = lds + PP_KI;
    f32x16 pacc;
#pragma unroll
    for (int i = 0; i < 16; ++i) pacc[i] = 0.f;
#pragma unroll
    for (int sl = 0; sl < NSLAB; ++sl) {
        const int d0 = 128 * sl;
        PrepIn nxt = cur;
        if (sl + 1 < NSLAB) prep_load<KIND>(nxt, tid, wave, proj_, b, h, c, sl + 1);
        else if (has_next) prep_load<KIND>(nxt, tid, wave, proj_, nb_, nh_, nc_, 0);
        const v4u q0 = cur.q0, q1 = cur.q1;
        {
            const int d = tid & 127, seg = wave >> 1;
            float w2[16]; float bb = 0.f, lb = 0.f;
            if constexpr (KIND == 0) {
#pragma unroll
                for (int q = 0; q < 16; ++q) w2[q] = w_a2_[q * 1024 + h * 256 + d0 + d];
                bb = b_a_[h * 256 + d0 + d];
            } else { lb = lbt_[h * 128 + d]; }
            float run = 0.f;
#pragma unroll
            for (int t = 0; t < 16; ++t) { const int i = seg * 16 + t; const size_t row = tok0 + i; float g, kv;
                if constexpr (KIND == 0) { float z = bb; const float* ga = ga1_ + row * 16;
#pragma unroll
                    for (int q = 0; q < 16; ++q) z += ga[q] * w2[q];
                    g = (fminf(z, 0.f) - __logf(1.0f + __expf(-fabsf(z)))) * 0.0625f; kv = bf2f(cur.kin[t]); }
                else { const float hf = bf2f(cur.kin[t]); const float f = lb + (1.0f - lb) * sigmoidf_(hf); g = __logf(f); kv = 1.0f - f; }
                run += g; Gs[i * 132 + d] = run; Ks[i * 132 + d] = kv; }
            SEGT[seg * 128 + d] = run;
        }
        __syncthreads();
        {   const int d = tid & 127, seg = wave >> 1; const float t0 = SEGT[d], t1 = SEGT[128 + d], t2 = SEGT[256 + d], t3 = SEGT[384 + d];
            const float off = seg == 0 ? 0.f : (seg == 1 ? t0 : (seg == 2 ? t0 + t1 : (t0 + t1) + t2));
            if (seg > 0) {
#pragma unroll
                for (int t = 0; t < 16; ++t) Gs[(seg * 16 + t) * 132 + d] += off; }
            if (seg == 3) { const float gt = off + t3; GT[d] = gt; LAM[d0 + d] = __expf(gt); }
        }
        __syncthreads();
        {
            const int ks = tid & 7, i = tid >> 3;
            float qv[16];
            qv[0] = bf2f(q0.x & 0xffffu); qv[1] = bf2f(q0.x >> 16); qv[2] = bf2f(q0.y & 0xffffu); qv[3] = bf2f(q0.y >> 16); qv[4] = bf2f(q0.z & 0xffffu); qv[5] = bf2f(q0.z >> 16); qv[6] = bf2f(q0.w & 0xffffu); qv[7] = bf2f(q0.w >> 16);
            qv[8] = bf2f(q1.x & 0xffffu); qv[9] = bf2f(q1.x >> 16); qv[10] = bf2f(q1.y & 0xffffu); qv[11] = bf2f(q1.y >> 16); qv[12] = bf2f(q1.z & 0xffffu); qv[13] = bf2f(q1.z >> 16); qv[14] = bf2f(q1.w & 0xffffu); qv[15] = bf2f(q1.w >> 16);
            float qt[16], kh[16], qp_[16];
#pragma unroll
            for (int q4 = 0; q4 < 4; ++q4) { const f32x4 g4 = *(const LAS f32x4*)(Gs + i * 132 + 16 * ks + 4 * q4), k4 = *(const LAS f32x4*)(Ks + i * 132 + 16 * ks + 4 * q4), t4 = *(const LAS f32x4*)(GT + 16 * ks + 4 * q4);
#pragma unroll
                for (int p = 0; p < 4; ++p) { const int dd = 4 * q4 + p; const float qq = KIND == 0 ? qv[dd] * 0.0625f : qv[dd] * sigmoidf_(qv[dd]);
                    qt[dd] = qq * __expf(g4[p]); qp_[dd] = qq * __expf(g4[p] - t4[p]); kh[dd] = k4[p] * __expf(-g4[p]); } }
#pragma unroll
            for (int h2 = 0; h2 < 2; ++h2) { const int slot = ((2 * ks + h2) ^ i) & 15;
                *(LAS v4u*)(QI + i * 256 + slot * 16) = piece16(qt, h2); *(LAS v4u*)(KH + i * 256 + slot * 16) = piece16(kh, h2);
                *(v4u*)(QF + (size_t)i * (DK * 2) + sl * 256 + slot * 16) = piece16(qp_, h2); }
        }
        __syncthreads();
        if (wave < 3) {
            const int jt = wave == 2 ? 1 : 0, it = wave == 0 ? 0 : 1, j = 32 * jt + r, i = 32 * it + r;
#pragma unroll
            for (int ks = 0; ks < 8; ++ks) { const bf16x8 a = *(const LAS bf16x8*)(KH + j * 256 + (((2 * ks + hh) ^ j) & 15) * 16), bq = *(const LAS bf16x8*)(QI + i * 256 + (((2 * ks + hh) ^ i) & 15) * 16);
                pacc = __builtin_amdgcn_mfma_f32_32x32x16_bf16(a, bq, pacc, 0, 0, 0); }
        }
        {
            const int d = tid & 127, s4 = tid >> 7; const float gt = GT[d]; float kt[16];
#pragma unroll
            for (int t = 0; t < 16; ++t) { const int j = 16 * s4 + t; kt[t] = Ks[j * 132 + d] * __expf(gt - Gs[j * 132 + d]); }
#pragma unroll
            for (int h2 = 0; h2 < 2; ++h2) *(LAS v4u*)(KI + d * 128 + (((2 * s4 + h2) ^ (d >> 1)) & 7) * 16) = piece16(kt, h2);
        }
        __syncthreads();
#pragma unroll
        for (int q = 0; q < 2; ++q) { const int pc = tid + 512 * q; *(v4u*)(KF + (size_t)d0 * 128 + pc * 16) = *(const LAS v4u*)(KI + pc * 16); }
        __syncthreads();
        cur = nxt;
    }
    if (wave < 3) {
        if (wave != 1) {
#pragma unroll
            for (int q = 0; q < 16; ++q) if (crow(q, hh) > r) pacc[q] = 0.f; }
#pragma unroll
        for (int s2 = 0; s2 < 2; ++s2) { v4u w; w.x = cvtpk(pacc[8 * s2 + 0], pacc[8 * s2 + 1]); w.y = cvtpk(pacc[8 * s2 + 2], pacc[8 * s2 + 3]); w.z = cvtpk(pacc[8 * s2 + 4], pacc[8 * s2 + 5]); w.w = cvtpk(pacc[8 * s2 + 6], pacc[8 * s2 + 7]);
            *(v4u*)(PF + (2 * wave + s2) * 1024 + lane * 16) = w; }
    }
}

__device__ __forceinline__ const bf16* vblock_src(int u, const bf16* proj_) {
    if (u < 4096) { const int pc = u >> 2, eb = u & 3, pair = pc >> 7, c = pc & 127; return proj_ + ((size_t)(pair >> 2) * SEQ + (size_t)c * 64) * NPROJ + GV + (pair & 3) * 512 + eb * 128; }
    const int pc = u - 4096, pair = pc >> 7, c = pc & 127; return proj_ + ((size_t)(pair >> 4) * SEQ + (size_t)c * 64) * NPROJ + HI + (pair & 15) * 128;
}
__device__ __forceinline__ void vblock_load(v2u (&vin)[4], const bf16* src, int tid) {
#pragma unroll
    for (int q = 0; q < 4; ++q) vin[q] = *(const v2u*)(src + (size_t)((tid >> 5) + 16 * q) * NPROJ + (tid & 31) * 4);
}
__device__ __forceinline__ void vblock_run(LAS unsigned char* lds, int tid, const v2u (&vin)[4], unsigned char* dst) {
    LAS float* Ks = (LAS float*)(lds + PP_KS); LAS unsigned char* KI = lds + PP_KI;
#pragma unroll
    for (int q = 0; q < 4; ++q) { const int j = (tid >> 5) + 16 * q, e4 = (tid & 31) * 4; const v2u w = vin[q]; *(LAS f32x4*)(Ks + j * 132 + e4) = (f32x4){bf2f(w.x & 0xffffu), bf2f(w.x >> 16), bf2f(w.y & 0xffffu), bf2f(w.y >> 16)}; }
    __syncthreads();
    {   const int e = tid & 127, s4 = tid >> 7; float vv[16];
#pragma unroll
        for (int t = 0; t < 16; ++t) vv[t] = Ks[(16 * s4 + t) * 132 + e];
#pragma unroll
        for (int h2 = 0; h2 < 2; ++h2) *(LAS v4u*)(KI + e * 128 + (((2 * s4 + h2) ^ (e >> 1)) & 7) * 16) = piece16(vv, h2);
    }
    __syncthreads();
#pragma unroll
    for (int q = 0; q < 2; ++q) { const int pc = tid + 512 * q; *(v4u*)(dst + pc * 16) = *(const LAS v4u*)(KI + pc * 16); }
    __syncthreads();
}

__device__ __forceinline__ void lds_wait_ge(volatile LAS unsigned* p, unsigned want) { unsigned n = 0; while (*p < want) { __builtin_amdgcn_s_sleep(1); if (++n > (1u << 22)) break; } }
template <int KIND>
__device__ __forceinline__ void scan_item(LAS unsigned char* lds, volatile LAS unsigned* flg, int role, int lane, unsigned seq0, int pflags, const unsigned char* QF, const unsigned char* KF, const unsigned char* PF, const unsigned char* LAM, const unsigned char* VF, bf16* out) {
    constexpr int DK = KIND == 0 ? 256 : 128, DV = KIND == 0 ? 512 : 128, NDT = DK / 32, QB = 64 * DK * 2, KB = DK * 128, VB = DV * 128, NC = KIND == 0 ? 2 : 4;
    constexpr int SQ = 0, SK = QB, SP = QB + KB, SL = SP + 6144, SV = SL + 1024, STG = SV + NC * 4096;
    static_assert(2 * STG <= MISC_OFF, "scan stages fit under the LDS control words");
#define DMA1(gu, l) __builtin_amdgcn_global_load_lds((const unsigned*)((const unsigned char*)(gu) + (size_t)loff), (LAS unsigned*)(l), 16, 0, 0)
    if ((pflags & 32) && role >= NC) return;
    if (role == NC || role == NC + 2) {
        unsigned loff = (unsigned)lane * 16u; asm volatile("" : "+v"(loff));
        unsigned lvoff = (unsigned)(lane >> 2) * (unsigned)(NPROJ * 2) + (unsigned)(lane & 3) * 16u; asm volatile("" : "+v"(lvoff));
#pragma nounroll
        for (int c = 0; c < 128; ++c) { const unsigned seq = seq0 + c; const int st = seq & 1; LAS unsigned char* sb_ = lds + st * STG;
            if (st != ((role - NC) >> 1)) continue;
#pragma unroll
            for (int k = 0; k < NC; ++k) lds_wait_ge(flg + 4 + 4 * st + k, seq >> 1);
            asm volatile("" ::: "memory");
            const unsigned char* g_;
#pragma unroll
            for (int k = 0; k < NC; ++k)
#pragma unroll
                for (int q_ = 0; q_ < 4; ++q_) __builtin_amdgcn_global_load_lds((const unsigned*)(VF + ((size_t)c * 64 + 16 * q_) * (NPROJ * 2) + k * 64 + (size_t)lvoff), (LAS unsigned*)(sb_ + SV + k * 4096 + q_ * 1024), 16, 0, 0);
            g_ = PF + (size_t)c * 6144;
#pragma unroll
            for (int q_ = 0; q_ < 6; ++q_) DMA1(g_ + q_ * 1024, sb_ + SP + q_ * 1024);
            DMA1(LAM + (size_t)c * 1024, sb_ + SL);
            g_ = QF + (size_t)c * QB;
#pragma unroll
            for (int q_ = 0; q_ < QB / 1024; ++q_) DMA1(g_ + q_ * 1024, sb_ + SQ + q_ * 1024);
            VM_WAIT(); flg[st] = seq + 1u; }
        return;
    }
    if (role == NC + 1 || role == NC + 3) {
        unsigned loff = (unsigned)lane * 16u; asm volatile("" : "+v"(loff));
#pragma nounroll
        for (int c = 0; c < 128; ++c) { const unsigned seq = seq0 + c; const int st = seq & 1; LAS unsigned char* sb_ = lds + st * STG;
            if (st != ((role - NC) >> 1)) continue;
#pragma unroll
            for (int k = 0; k < NC; ++k) lds_wait_ge(flg + 12 + 4 * st + k, seq >> 1);
            asm volatile("" ::: "memory");
            const unsigned char* g_ = KF + (size_t)c * KB;
#pragma unroll
            for (int q_ = 0; q_ < KB / 1024; ++q_) DMA1(g_ + q_ * 1024, sb_ + SK + q_ * 1024);
            VM_WAIT(); flg[2 + st] = seq + 1u; }
        return;
    }
#undef DMA1
    if (role > NC + 3) return;
    const int r = lane & 31, hh = lane >> 5;
    bf16* outw = out + role * 32;
    f32x16 S[NDT];
#pragma unroll
    for (int dt = 0; dt < NDT; ++dt)
#pragma unroll
        for (int q = 0; q < 16; ++q) S[dt][q] = 0.f;
#pragma nounroll
    for (int c = 0; c < 128; ++c) {
        const unsigned seq = seq0 + c; const int st = seq & 1;
        LAS unsigned char* base = lds + st * STG;
        if (!(pflags & 32)) lds_wait_ge(flg + st, seq + 1u);
        asm volatile("" ::: "memory");
        if (pflags & 16) { flg[4 + 4 * st + role] = (seq >> 1) + 1u; lds_wait_ge(flg + 2 + st, seq + 1u); flg[12 + 4 * st + role] = (seq >> 1) + 1u; continue; }
#define DSR(dst, addr) asm volatile("ds_read_b128 %0, %1" : "=v"(dst) : "v"(addr) : "memory")
#define LGK(n) do { asm volatile("s_waitcnt lgkmcnt(" #n ")" ::: "memory"); __builtin_amdgcn_sched_barrier(0); } while (0)
        constexpr int NKS = DK / 16;
        unsigned sbase = (unsigned)(size_t)base; asm volatile("" : "+v"(sbase));
        const unsigned aV = sbase + SV + role * 4096 + (4 * hh + ((lane & 15) >> 2)) * 64 + (16 * ((lane >> 4) & 1) + 4 * (lane & 3)) * 2, aP = sbase + SP + lane * 16;
        const unsigned aQ0 = (sbase + SQ + r * (DK * 2)) | ((((r >> 1) & 7) << 5) | (((r & 1) ^ hh) << 4));
        const unsigned aK = sbase + SK + r * 128, aL = sbase + SL + hh * 16;
        const unsigned swz = ((r >> 1) & 7) << 4;
        s16x4_t vt[4][2];
#define VFR(s_) __builtin_shufflevector(vt[s_][0], vt[s_][1], 0, 1, 2, 3, 4, 5, 6, 7)
        {
            f32x4 lm[2][4];
#pragma unroll
            for (int s_ = 0; s_ < 4; ++s_) DSR(lm[0][s_], aL + (unsigned)((8 * s_) * 4));
#pragma unroll
            for (int dt = 0; dt < NDT; ++dt) {
                __builtin_amdgcn_sched_barrier(0);
                if (dt + 1 < NDT) {
#pragma unroll
                    for (int s_ = 0; s_ < 4; ++s_) DSR(lm[(dt + 1) & 1][s_], aL + (unsigned)((32 * (dt + 1) + 8 * s_) * 4));
                    LGK(4); } else { LGK(0); }
#pragma unroll
                for (int g = 0; g < 4; ++g)
#pragma unroll
                    for (int p = 0; p < 4; ++p) S[dt][4 * g + p] *= lm[dt & 1][g][p];
                __builtin_amdgcn_sched_barrier(0);
            }
        }
        f32x16 O[2];
#pragma unroll
        for (int it = 0; it < 2; ++it)
#pragma unroll
            for (int q = 0; q < 16; ++q) O[it][q] = 0.f;
        bf16x8 qf[2][2], pf[6];
#define SCAN_LOADQ(buf, ks) do { const unsigned a_ = (aQ0 ^ (unsigned)((((ks) & 7) << 5))) + (unsigned)((((ks) >> 3) << 8)); DSR(qf[buf][0], a_); DSR(qf[buf][1], a_ + 32u * (DK * 2)); } while (0)
        SCAN_LOADQ(0, 0);
#pragma unroll
        for (int ks = 0; ks < NKS; ++ks) {
            __builtin_amdgcn_sched_barrier(0);
            if (ks + 1 < NKS) { SCAN_LOADQ((ks + 1) & 1, ks + 1); LGK(2); }
            else {
#pragma unroll
                for (int f = 0; f < 4; ++f) DSR(pf[f], aP + f * 1024);
#pragma unroll
                for (int s_ = 0; s_ < 4; ++s_) {
                    asm volatile("ds_read_b64_tr_b16 %0, %1" : "=v"(vt[s_][0]) : "v"(aV + (unsigned)((16 * s_) * 64)) : "memory");
                    asm volatile("ds_read_b64_tr_b16 %0, %1" : "=v"(vt[s_][1]) : "v"(aV + (unsigned)((16 * s_ + 8) * 64)) : "memory"); }
                LGK(12); }
            const int dt = ks >> 1, s2 = ks & 1;
            v4u sw; sw.x = cvtpk(S[dt][8 * s2 + 0], S[dt][8 * s2 + 1]); sw.y = cvtpk(S[dt][8 * s2 + 2], S[dt][8 * s2 + 3]); sw.z = cvtpk(S[dt][8 * s2 + 4], S[dt][8 * s2 + 5]); sw.w = cvtpk(S[dt][8 * s2 + 6], S[dt][8 * s2 + 7]);
            const bf16x8 sb = __builtin_bit_cast(bf16x8, sw);
            O[0] = __builtin_amdgcn_mfma_f32_32x32x16_bf16(sb, qf[ks & 1][0], O[0], 0, 0, 0);
            O[1] = __builtin_amdgcn_mfma_f32_32x32x16_bf16(sb, qf[ks & 1][1], O[1], 0, 0, 0);
            __builtin_amdgcn_sched_barrier(0);
        }
#undef SCAN_LOADQ
        __builtin_amdgcn_sched_barrier(0);
        DSR(pf[4], aP + 4 * 1024); DSR(pf[5], aP + 5 * 1024);
        LGK(2);

#pragma unroll
        for (int s = 0; s < 2; ++s) O[0] = __builtin_amdgcn_mfma_f32_32x32x16_bf16(VFR(s), pf[s], O[0], 0, 0, 0);
#pragma unroll
        for (int s = 0; s < 2; ++s) O[1] = __builtin_amdgcn_mfma_f32_32x32x16_bf16(VFR(s), pf[2 + s], O[1], 0, 0, 0);
        __builtin_amdgcn_sched_barrier(0);
        LGK(0);
#pragma unroll
        for (int s = 2; s < 4; ++s) O[1] = __builtin_amdgcn_mfma_f32_32x32x16_bf16(VFR(s), pf[2 + s], O[1], 0, 0, 0);
        __builtin_amdgcn_sched_barrier(0);
        flg[4 + 4 * st + role] = (seq >> 1) + 1u;
        if (!(pflags & 8)) {   const bf16* opu = outw + (size_t)c * 64 * D;
            unsigned lo = (unsigned)(r * D + 4 * hh) * 2u; asm volatile("" : "+v"(lo));
#pragma unroll
            for (int it = 0; it < 2; ++it)
#pragma unroll
                for (int g = 0; g < 4; ++g) { v2u w; w.x = cvtpk(O[it][4 * g + 0], O[it][4 * g + 1]); w.y = cvtpk(O[it][4 * g + 2], O[it][4 * g + 3]);
                    *(v2u*)((unsigned char*)(opu + (size_t)(32 * it) * D + 8 * g) + (size_t)lo) = w; } }
        if (!(pflags & 32)) lds_wait_ge(flg + 2 + st, seq + 1u);
        asm volatile("" ::: "memory");
        __builtin_amdgcn_sched_barrier(0);
        {
            constexpr int NF = 4 * NDT;
            bf16x8 ring[8];
#define SCAN_KADDR(j) (aK + (unsigned)(((j) % NDT) * 4096) + (unsigned)((((2 * ((j) / NDT) + hh) << 4) ^ swz) & 0x70))
#pragma unroll
            for (int j = 0; j < 8; ++j) DSR(ring[j], SCAN_KADDR(j));
#pragma unroll
            for (int j = 0; j < NF; ++j) {
                __builtin_amdgcn_sched_barrier(0);
                const int young = (NF - 1 - j) < 7 ? (NF - 1 - j) : 7;
                if (young == 7) LGK(7); else if (young == 6) LGK(6); else if (young == 5) LGK(5); else if (young == 4) LGK(4); else if (young == 3) LGK(3); else if (young == 2) LGK(2); else if (young == 1) LGK(1); else LGK(0);
                S[j % NDT] = __builtin_amdgcn_mfma_f32_32x32x16_bf16(ring[j & 7], VFR(j / NDT), S[j % NDT], 0, 0, 0);
                __builtin_amdgcn_sched_barrier(0);
                if (j + 8 < NF) DSR(ring[j & 7], SCAN_KADDR(j + 8));
            }
#undef SCAN_KADDR
        }
#undef DSR
#undef LGK
#undef VFR
        LDS_WAIT();
        flg[12 + 4 * st + role] = (seq >> 1) + 1u;
    }
}

struct Args { const float* in[25]; float* out; unsigned char* ws; int ph_lo, ph_hi, flags, pad; };
constexpr int N_PHASES = 17;

__global__ void __launch_bounds__(NTHREADS, 2) fwd_kernel(Args args) {
    extern __shared__ __attribute__((aligned(16))) unsigned char lds_raw[];
    LAS unsigned char* lds = (LAS unsigned char*)lds_raw;
    volatile LAS unsigned* MISC = (volatile LAS unsigned*)(lds + MISC_OFF);
    const int tid = threadIdx.x, lane = tid & 63, wave = __builtin_amdgcn_readfirstlane(tid >> 6);
    const int G = gridDim.x, bx = blockIdx.x;
    const int vcu = (G % 8 == 0) ? (bx % 8) * (G / 8) + bx / 8 : bx;
    const int gw = vcu * NWAVES + wave, NGW = G * NWAVES;
    unsigned* ctl = (unsigned*)(args.ws + WS_CTL);
#define x_in (args.in[0])
#define mem_in (args.in[1])
#define w_in (args.in[2])
#define b_in (args.in[3])
#define w_a2 (args.in[4])
#define b_a (args.in[5])
#define gla_g (args.in[6])
#define hgrn_g (args.in[7])
#define lb_logits (args.in[8])
#define w_mix_o (args.in[9])
#define w_xq (args.in[10])
#define w_mem_kv (args.in[11])
#define w_xo (args.in[12])
#define w_router (args.in[13])
#define b_router (args.in[14])
#define w_gate_up (args.in[15])
#define b_gate_up (args.in[16])
#define w_down (args.in[17])
#define b_down (args.in[18])
#define ln1_g (args.in[19])
#define ln1_b (args.in[20])
#define ln2_g (args.in[21])
#define ln2_b (args.in[22])
#define ln3_g (args.in[23])
#define ln3_b (args.in[24])
#define WSP(type, off) ((type*)(args.ws + (off)))
#define ws_ (args.ws)
#define Win_t WSP(bf16, WS_WIN_T)
#define Wo_t WSP(bf16, WS_WO_T)
#define Wxq_t WSP(bf16, WS_WXQ_T)
#define Wkv_t WSP(bf16, WS_WKV_T)
#define Wxo_t WSP(bf16, WS_WXO_T)
#define Wgu_t WSP(bf16, WS_WGU_T)
#define Wd_t WSP(bf16, WS_WD_T)
#define xb WSP(bf16, WS_XB)
#define memb WSP(bf16, WS_MEMB)
#define ga1 WSP(float, WS_GA1)
#define binc WSP(float, WS_BINC)
#define bgup WSP(float, WS_BGUP)
#define lbt WSP(float, WS_LB)
#define proj WSP(bf16, WS_PROJ)
#define glog WSP(float, WS_GLOG)
#define ogla WSP(float, WS_OGLA)
#define oh WSP(float, WS_OH)
#define merged WSP(bf16, WS_MERGED)
#define pre1 WSP(float, WS_PRE1)
#define h1 WSP(float, WS_H1)
#define h1b WSP(bf16, WS_H1B)
#define qb WSP(bf16, WS_Q)
#define kk WSP(bf16, WS_KK)
#define vt WSP(bf16, WS_VT)
#define sc WSP(float, WS_SC)
#define Pb WSP(bf16, WS_P)
#define ao WSP(bf16, WS_AO)
#define pre2 WSP(float, WS_PRE2)
#define h2 WSP(float, WS_H2)
#define h2b WSP(bf16, WS_H2B)
#define list WSP(int, WS_LIST)
#define gates WSP(float, WS_GATES)
#define act WSP(bf16, WS_ACT)
#define ybuf WSP(bf16, WS_YBUF)
#define ecnt (ctl + CW_CNT)

    for (int u = tid; u < (LDS_BYTES - MISC_OFF) / 4; u += NTHREADS) ((LAS unsigned*)(lds + MISC_OFF))[u] = 0u;
    __syncthreads();
    const int lo = args.ph_lo, hi = args.ph_hi;
    const bool multi = (hi - lo) > 1;
    XcdBarrier bar; bar.bar = ctl + CW_BAR; bar.x = 0; bar.st = nullptr;
    if (multi) bar = xcd_barrier_post(ctl + CW_BAR, MISC + 8);
#ifndef PHMASK
#define PHMASK 0x1FFFF
#endif
#define IN(k) (((PHMASK >> (k)) & 1) && lo <= (k) && (k) < hi)
#define SEAM(k) do { if (IN(k) && IN((k) + 1)) xcd_barrier(bar); } while (0)

    if (IN(0)) {
        {
            const int idx = bx * 512 + tid;
            if (idx < D * NE) { const float w = w_router[idx]; const unsigned h = pk2(w, 0.f) & 0xffffu; const float r = w - __uint_as_float(h << 16); const unsigned l = pk2(r, 0.f) & 0xffffu;
                const int k = idx >> 5, e = idx & 31; WSP(unsigned short, WS_WRH)[e * D + k] = (unsigned short)h; WSP(unsigned short, WS_WRL)[e * D + k] = (unsigned short)l; }
            if (G * 512 < D * NE) for (int i2 = idx + G * 512; i2 < D * NE; i2 += G * 512) { const float w = w_router[i2]; const unsigned h = pk2(w, 0.f) & 0xffffu; const float r = w - __uint_as_float(h << 16); const unsigned l = pk2(r, 0.f) & 0xffffu;
                const int k = i2 >> 5, e = i2 & 31; WSP(unsigned short, WS_WRH)[e * D + k] = (unsigned short)h; WSP(unsigned short, WS_WRL)[e * D + k] = (unsigned short)l; }
        }
        {
            const int nnb0 = (DIN + 63) / 64;
            for (int it = gw; it < nnb0 * 32; it += NGW) transpose_item(w_in, DIN, NPROJ, 1, Win_t, it, nnb0, lane);
            for (int it = gw; it < 64 * 32; it += NGW) transpose_item(w_mem_kv, 2 * D, 2 * D, 0, Wkv_t, it, 64, lane);
            for (int it = gw; it < N_FP8_TILES * 8 * 16; it += NGW) transpose_item_fp8(w_in, DIN, N_FP8_TILES * 256, 3, ws_ + WS_GLOG + 32 * MiB, it, N_FP8_TILES * 8, lane, 256.0f);
        }
        {   LAS float* W1t = (LAS float*)lds;
            for (int idx = tid; idx < D * 4; idx += NTHREADS) { const int c = idx >> 2, q4 = idx & 3; const f32x4 w4 = *(const f32x4*)(w_in + (size_t)c * DIN + GA1_COL + 4 * q4);
                W1t[(4 * q4 + 0) * D + c] = w4[0]; W1t[(4 * q4 + 1) * D + c] = w4[1]; W1t[(4 * q4 + 2) * D + c] = w4[2]; W1t[(4 * q4 + 3) * D + c] = w4[3]; }
            __syncthreads();
            f32x4 vn[8];
            if (gw < T) {
#pragma unroll
                for (int j = 0; j < 8; ++j) vn[j] = *(const f32x4*)(x_in + (size_t)gw * D + 4 * lane + 256 * j); }
            for (int row = gw; row < T; row += NGW) {
                f32x4 v[8];
#pragma unroll
                for (int j = 0; j < 8; ++j) v[j] = vn[j];
                if (row + NGW < T) {
#pragma unroll
                    for (int j = 0; j < 8; ++j) vn[j] = *(const f32x4*)(x_in + (size_t)(row + NGW) * D + 4 * lane + 256 * j); }
                row_store_bf16(xb + (size_t)row * D, v, lane);
#pragma unroll
                for (int j = 0; j < 8; ++j) *(unsigned*)(ws_ + WS_GLOG + (size_t)row * D + 4 * lane + 256 * j) = pk4_fp8(v[j][0], v[j][1], v[j][2], v[j][3]);
                float mine = 0.f;
#pragma unroll 2
                for (int r16 = 0; r16 < 16; ++r16) { float p = 0.f;
#pragma unroll
                    for (int j = 0; j < 8; ++j) { const f32x4 w4 = *(const LAS f32x4*)(W1t + r16 * D + 4 * lane + 256 * j); p += (v[j][0] * w4[0] + v[j][1] * w4[1]) + (v[j][2] * w4[2] + v[j][3] * w4[3]); }
                    const float sum = wave_sum(p); if (lane == r16) mine = sum; }
                if (lane < 16) ga1[(size_t)row * 16 + lane] = mine + b_in[GA1_COL + lane];
            }
        }
        for (int row = gw; row < NBATCH * NMEM; row += NGW) {
            f32x4 v[8];
#pragma unroll
            for (int j = 0; j < 8; ++j) v[j] = *(const f32x4*)(mem_in + (size_t)row * D + 4 * lane + 256 * j);
            row_store_bf16(memb + (size_t)row * D, v, lane);
        }
        for (int i = bx * NTHREADS + tid; i < NPROJ; i += G * NTHREADS) binc[i] = b_in[i < GA1_COL ? i : i + 16];
        for (int i = bx * NTHREADS + tid; i < NE * 4096; i += G * NTHREADS) { const int e = i >> 12, n = i & 4095; bgup[e * 4096 + tmap(2, n)] = b_gate_up[i]; }
        for (int i = bx * NTHREADS + tid; i < D; i += G * NTHREADS) { const float l0 = lb_logits[i], l1 = lb_logits[D + i]; const float m = fmaxf(l0, l1); const float e0 = __expf(l0 - m), e1 = __expf(l1 - m); lbt[i] = e0 / (e0 + e1); }
    }
    SEAM(0);
    if (IN(1)) {
        {
            pg8::SchedSel S{(const char*)xb, (const char*)Win_t, T / 256, N_BF16_TILES, G, bx, (size_t)256 * D * 2, (size_t)256 * D * 2, 0};
            pg8::EpiBf16G E{proj, NPROJ, binc, 1.0f, 1.0f};
            pg8::gemm_phase<pg8::EpiBf16G, pg8::SchedSel, false>(lds, D, D, D, S, E); }
        {
            pg8::SchedSel S{(const char*)(ws_ + WS_GLOG), (const char*)(ws_ + WS_GLOG + 32 * MiB), T / 256, N_FP8_TILES, G, bx, (size_t)256 * D, (size_t)256 * D, 1};
            pg8::EpiBf16G E{proj, NPROJ, binc, 1.0f, 1.0f / 256.0f};
            pg8::gemm_phase<pg8::EpiBf16G, pg8::SchedSel, false, 1>(lds, D, D, D, S, E); }
    }
    SEAM(1);
    if (IN(3)) {
        {
            pg8::SchedKV S{(const char*)memb, (const char*)Wkv_t, G, bx};
            pg8::EpiKV E{kk, vt};
            pg8::gemm_phase<pg8::EpiKV, pg8::SchedKV, false>(lds, D, D, D, S, E);
        }
        {   PrepIn cur;
            if (bx < 1024) prep_load<0>(cur, tid, wave, proj, (bx >> 7) >> 2, (bx >> 7) & 3, bx & 127, 0);
            for (int u = bx; u < 1024; u += G) { const int pair = u >> 7, c = u & 127; const size_t pc = (size_t)pair * 128 + c; const int un = u + G; const bool hn = un < 1024;
                prep_unit<0>(lds, tid, pair >> 2, pair & 3, c, (un >> 7) >> 2, (un >> 7) & 3, un & 127, hn, cur, proj, ga1, w_a2, b_a, lbt, ws_ + WS_QFG + pc * 32768, ws_ + WS_KFG + pc * 32768, ws_ + WS_PFG + pc * 6144, (float*)(ws_ + WS_LAMG + pc * 1024), ws_ + WS_VFG + pc * 65536); }
            unsigned* hq = ctl + CW_HQ;
            if (tid == 0) MISC[40] = __hip_atomic_fetch_add(hq, 1u, RLX_AGENT);
            __syncthreads();
            int u = (int)MISC[40];
            if (u < 4096) prep_load<1>(cur, tid, wave, proj, (u >> 7) >> 4, (u >> 7) & 15, u & 127, 0);
            while (u < 4096) {
                __syncthreads();
                if (tid == 0) MISC[40] = __hip_atomic_fetch_add(hq, 1u, RLX_AGENT);
                __syncthreads();
                const int un = (int)MISC[40]; const bool hn = un < 4096;
                const int pair = u >> 7, c = u & 127; const size_t pc = (size_t)pair * 128 + c;
                prep_unit<1>(lds, tid, pair >> 4, pair & 15, c, (un >> 7) >> 4, (un >> 7) & 15, un & 127, hn, cur, proj, ga1, w_a2, b_a, lbt, ws_ + WS_QFH + pc * 16384, ws_ + WS_KFH + pc * 16384, ws_ + WS_PFH + pc * 6144, (float*)(ws_ + WS_LAMH + pc * 1024), ws_ + WS_VFH + pc * 16384);
                u = un;
            }
        }
    }
    SEAM(3);
    if (IN(4)) {
        const int NSCAN = 96; const bool split = G >= 192;
        volatile LAS unsigned* flg = MISC + 16;
        if (!(args.flags & 2) && (!split || bx < NSCAN)) {
            unsigned seq0 = 0u;
            for (int it = bx; it < NSCAN; it += (split ? NSCAN : G), seq0 += 128u) {
                if (it < 64) { const int pair = it & 7, e2 = it >> 3;
                    scan_item<0>(lds, flg, wave, lane, seq0, args.flags, ws_ + WS_QFG + (size_t)pair * 128 * 32768, ws_ + WS_KFG + (size_t)pair * 128 * 32768, ws_ + WS_PFG + (size_t)pair * 128 * 6144, ws_ + WS_LAMG + (size_t)pair * 128 * 1024,
                                 (const unsigned char*)(proj + (size_t)(pair >> 2) * SEQ * NPROJ + GV + (pair & 3) * 512 + e2 * 64), (bf16*)ogla + (size_t)(pair >> 2) * SEQ * D + (pair & 3) * 512 + e2 * 64);
                } else { const int pair = it - 64;
                    scan_item<1>(lds, flg, wave, lane, seq0, args.flags, ws_ + WS_QFH + (size_t)pair * 128 * 16384, ws_ + WS_KFH + (size_t)pair * 128 * 16384, ws_ + WS_PFH + (size_t)pair * 128 * 6144, ws_ + WS_LAMH + (size_t)pair * 128 * 1024,
                                 (const unsigned char*)(proj + (size_t)(pair >> 4) * SEQ * NPROJ + HI + (pair & 15) * 128), (bf16*)oh + (size_t)(pair >> 4) * SEQ * D + (pair & 15) * 128);
                }
            }
        }
        if (!(args.flags & 1) && (!split || bx >= NSCAN)) {
            if (!split) __syncthreads();
            constexpr int CWAVES = 8;
            if (split && wave >= CWAVES) {   } else {
            const int cw = split ? (bx - NSCAN) * CWAVES + wave : gw, NCW = split ? (G - NSCAN) * CWAVES : NGW;
            for (int it = cw; it < 32 * 32; it += NCW) transpose_item(w_mix_o, D, D, 0, Wo_t, it, 32, lane);
            for (int it = cw; it < 64 * 16; it += NCW) transpose_item_fp8(w_xq, D, D, 0, (unsigned char*)Wxq_t, it, 64, lane, 256.0f, ln1_g);
            for (int it = cw; it < 64 * 16; it += NCW) transpose_item_fp8(w_xo, D, D, 0, (unsigned char*)Wxo_t, it, 64, lane, 256.0f);
            for (int it = cw; it < 128 * 16 * NE; it += NCW) transpose_item_fp8(w_gate_up, 2 * D, 2 * D, 2, (unsigned char*)Wgu_t, it, 128, lane, 256.0f);
            for (int it = cw; it < 64 * 16 * NE; it += NCW) transpose_item_fp8(w_down, D, D, 0, (unsigned char*)Wd_t, it, 64, lane, 256.0f);
            }
        }
    }
    SEAM(4);
    if (IN(5)) {
        if (bx < 64) {
            const int cq = tid & 7, ks = tid >> 3;
            const float* src = w_xq + (size_t)ks * D + bx * 32 + 4 * cq;
            f32x4 s1 = {0.f, 0.f, 0.f, 0.f}, s2 = {0.f, 0.f, 0.f, 0.f};
#pragma unroll 8
            for (int i = 0; i < 32; ++i) { const f32x4 w = *(const f32x4*)(src + (size_t)64 * i * D); s1 += ln1_g[ks + 64 * i] * w; s2 += ln1_b[ks + 64 * i] * w; }
            LAS f32x4* red = (LAS f32x4*)lds;
            red[(ks * 8 + cq) * 2] = s1; red[(ks * 8 + cq) * 2 + 1] = s2;
            __syncthreads();
            if (tid < 64) { const int which = tid >> 5, col = tid & 31; float a = 0.f;
                for (int k2 = 0; k2 < 64; ++k2) a += ((LAS float*)lds)[((k2 * 8 + (col >> 2)) * 2 + which) * 4 + (col & 3)];
                WSP(float, WS_C12)[which * D + bx * 32 + col] = a; }
            __syncthreads();
        }
        for (int row = gw; row < T; row += NGW) {
            const bf16* pr = proj + (size_t)row * NPROJ;
            v4u aw[4], hw[4], grw[4], hgw[4], maw[4], mbw[4];
#pragma unroll
            for (int j2 = 0; j2 < 4; ++j2) { const int c = 8 * lane + 512 * j2; aw[j2] = *(const v4u*)((const bf16*)ogla + (size_t)row * D + c); hw[j2] = *(const v4u*)((const bf16*)oh + (size_t)row * D + c);
                grw[j2] = *(const v4u*)(pr + GR + c); hgw[j2] = *(const v4u*)(pr + HG + c); maw[j2] = *(const v4u*)(pr + MA + c); mbw[j2] = *(const v4u*)(pr + MB + c); }
#pragma unroll
            for (int j2 = 0; j2 < 4; ++j2) {
                int lo8 = 8 * lane; asm volatile("" : "+v"(lo8));
                const f32x4 gn0 = *(const f32x4*)(gla_g + lo8), gn1 = *(const f32x4*)(gla_g + lo8 + 4), hn0 = *(const f32x4*)(hgrn_g + (lo8 & 127)), hn1 = *(const f32x4*)(hgrn_g + (lo8 & 127) + 4);
                f32x4 a0, a1, h0, h1_, g0, g1, q0, q1, m0, m1, n0, n1;
                bf16x8_to_f32(aw[j2], a0, a1); bf16x8_to_f32(hw[j2], h0, h1_); bf16x8_to_f32(grw[j2], g0, g1); bf16x8_to_f32(hgw[j2], q0, q1); bf16x8_to_f32(maw[j2], m0, m1); bf16x8_to_f32(mbw[j2], n0, n1);
                float sg = ((a0[0] * a0[0] + a0[1] * a0[1]) + (a0[2] * a0[2] + a0[3] * a0[3])) + ((a1[0] * a1[0] + a1[1] * a1[1]) + (a1[2] * a1[2] + a1[3] * a1[3]));
                const float rg = __builtin_amdgcn_rsqf(wave_sum(sg) * (1.0f / 512.0f) + EPS);
                float sh = ((h0[0] * h0[0] + h0[1] * h0[1]) + (h0[2] * h0[2] + h0[3] * h0[3])) + ((h1_[0] * h1_[0] + h1_[1] * h1_[1]) + (h1_[2] * h1_[2] + h1_[3] * h1_[3]));
                sh += __shfl_xor(sh, 1); sh += __shfl_xor(sh, 2); sh += __shfl_xor(sh, 4); sh += __shfl_xor(sh, 8);
                const float rh = __builtin_amdgcn_rsqf(sh * (1.0f / 128.0f) + EPS);
                f32x4 o0, o1;
#pragma unroll
                for (int k = 0; k < 4; ++k) {
                    o0[k] = sigmoidf_(m0[k]) * (a0[k] * rg * gn0[k] * (g0[k] * sigmoidf_(g0[k]))) + sigmoidf_(n0[k]) * (h0[k] * rh * hn0[k] * sigmoidf_(q0[k]));
                    o1[k] = sigmoidf_(m1[k]) * (a1[k] * rg * gn1[k] * (g1[k] * sigmoidf_(g1[k]))) + sigmoidf_(n1[k]) * (h1_[k] * rh * hn1[k] * sigmoidf_(q1[k])); }
                v4u w; w.x = pk2(o0[0], o0[1]); w.y = pk2(o0[2], o0[3]); w.z = pk2(o1[0], o1[1]); w.w = pk2(o1[2], o1[3]);
                *(v4u*)(merged + (size_t)row * D + 8 * lane + 512 * j2) = w;
                if (j2 & 1) __builtin_amdgcn_sched_barrier(0);
            }
        }
    }
    SEAM(5);
    if (IN(6)) {
        pg8::SchedDense S{(const char*)merged, (const char*)Wo_t, T / 256, D / 256, G, bx, (size_t)256 * D * 2, (size_t)256 * D * 2};
        pg8::EpiPre1 E{(bf16*)pre1, (unsigned char*)h1, D, x_in, ALPHA, WSP(float, WS_STAT)};
        pg8::gemm_phase<pg8::EpiPre1, pg8::SchedDense, false>(lds, D, D, D, S, E);
    }
    SEAM(6);
    const bool own_chain = IN(8) && IN(9) && IN(11) && G == 256;
    if (IN(7) && !own_chain) {
        for (int row = bx * 512 + tid; row < T; row += G * 512) ln1_finish(WSP(float, WS_STAT), WSP(float, WS_FST), row);
    }
    if (!own_chain) SEAM(7);
    if (own_chain) {
        pg8::Unit u0; pg8::static_next(T / 256, XH, G, bx, 0, u0);
        const int opm = __builtin_amdgcn_readfirstlane(u0.pm), oh_ = __builtin_amdgcn_readfirstlane(u0.pn);
        if (tid < 256) ln1_finish(WSP(float, WS_STAT), WSP(float, WS_FST) + (size_t)oh_ * T * 2, opm * 256 + tid);
        __syncthreads();
        {   pg8::SchedOwn<pg8::SchedDense> S{{(const char*)h1, (const char*)Wxq_t, T / 256, D / 256, G, bx, (size_t)256 * D, (size_t)256 * D}, opm, 2 * oh_, 2};
            int oh2 = oh_; asm volatile("" : "+s"(oh2));
            pg8::EpiQFold E{qb, D, WSP(float, WS_FST) + (size_t)oh2 * T * 2, WSP(float, WS_C12), WSP(float, WS_C12) + D, 0.04419417382415922f, 1.0f / 256.0f};
            pg8::gemm_phase<pg8::EpiQFold, pg8::SchedOwn<pg8::SchedDense>, false, 1>(lds, D, D, D, S, E); }
        {   pg8::SchedOwn<pg8::SchedScores> S{{(const char*)qb, (const char*)kk, G, bx}, opm, oh_, 1};
            pg8::EpiSoftmax E{Pb, 1024, (LAS float*)(lds + RING_BYTES)};
            pg8::gemm_phase<pg8::EpiSoftmax, pg8::SchedOwn<pg8::SchedScores>, false>(lds, XDH, D, D, S, E); }
        {   pg8::SchedOwn<pg8::SchedPV> S{{(const char*)Pb, (const char*)vt, G, bx}, opm, 2 * oh_, 2};
            pg8::EpiFp8 E{(unsigned char*)ao, D, 16.0f};
            pg8::gemm_phase<pg8::EpiFp8, pg8::SchedOwn<pg8::SchedPV>, false>(lds, NMEM, 1024, 512, S, E); }
    } else {
    if (IN(8)) {
        pg8::SchedDense S{(const char*)h1, (const char*)Wxq_t, T / 256, D / 256, G, bx, (size_t)256 * D, (size_t)256 * D};
        pg8::EpiQFold E{qb, D, WSP(float, WS_FST), WSP(float, WS_C12), WSP(float, WS_C12) + D, 0.04419417382415922f, 1.0f / 256.0f};
        pg8::gemm_phase<pg8::EpiQFold, pg8::SchedDense, false, 1>(lds, D, D, D, S, E);
    }
    SEAM(8);
    if (IN(9)) {
        pg8::SchedScores S{(const char*)qb, (const char*)kk, G, bx};
        pg8::EpiSoftmax E{Pb, 1024, (LAS float*)(lds + RING_BYTES)};
        pg8::gemm_phase<pg8::EpiSoftmax, pg8::SchedScores, false>(lds, XDH, D, D, S, E);
    }
    if (IN(9) && IN(11)) xcd_barrier(bar);
    if (IN(11)) {
        pg8::SchedPV S{(const char*)Pb, (const char*)vt, G, bx};
        pg8::EpiFp8 E{(unsigned char*)ao, D, 16.0f};
        pg8::gemm_phase<pg8::EpiFp8, pg8::SchedPV, false>(lds, NMEM, 1024, 512, S, E);
    }
    }
    SEAM(11);
    if (IN(12)) {
        pg8::SchedDense S{(const char*)ao, (const char*)Wxo_t, T / 256, D / 256, G, bx, (size_t)256 * D, (size_t)256 * D};
        pg8::EpiXoFold E{(bf16*)pre2, D, (const bf16*)pre1, WSP(float, WS_FST), ln1_g, ln1_b, ALPHA, 1.0f / 4096.0f};
        pg8::gemm_phase<pg8::EpiXoFold, pg8::SchedDense, false, 1>(lds, D, D, D, S, E);
    }
    SEAM(12);
    if (IN(13)) {
        LAS int* lcnt = (LAS int*)(lds);
        LAS int* lbase = (LAS int*)(lds + 128);
        LAS int* lsel = (LAS int*)(lds + 256);
        constexpr int ARS = 4096 + 16;
        LAS unsigned char* AH = lds + 4096; LAS unsigned char* AL = lds + 4096 + 16 * ARS;
        LAS float* PART = (LAS float*)(lds + 4096 + 32 * ARS);
        const bool side = !(args.flags & 4);
#define ROUTER_LN(p_, q_) do { const int lr_ = 2 * wave + (q_); const int row_ = rb * 64 + (p_) * 16 + lr_; f32x4 v[8]; int lane_ = lane; asm volatile("" : "+v"(lane_));        \
            _Pragma("unroll") for (int j2 = 0; j2 < 4; ++j2) bf16x8_to_f32(raw[q_][j2], v[2 * j2], v[2 * j2 + 1]); float mu_, rs_; ln_apply_b_st(v, ln2_g, ln2_b, lane_, mu_, rs_); if (lane == 0) *(f32x2*)(WSP(float, WS_ST2) + 2 * (size_t)row_) = (f32x2){mu_, rs_}; \
            _Pragma("unroll") for (int j2 = 0; j2 < 4; ++j2) { const f32x4 a_ = v[2 * j2], b_ = v[2 * j2 + 1]; v4u hi_, lo_; \
                hi_.x = pk2(a_[0], a_[1]); hi_.y = pk2(a_[2], a_[3]); hi_.z = pk2(b_[0], b_[1]); hi_.w = pk2(b_[2], b_[3]); \
                lo_.x = pk2(a_[0] - __uint_as_float(hi_.x << 16), a_[1] - __uint_as_float(hi_.x & 0xffff0000u)); lo_.y = pk2(a_[2] - __uint_as_float(hi_.y << 16), a_[3] - __uint_as_float(hi_.y & 0xffff0000u)); \
                lo_.z = pk2(b_[0] - __uint_as_float(hi_.z << 16), b_[1] - __uint_as_float(hi_.z & 0xffff0000u)); lo_.w = pk2(b_[2] - __uint_as_float(hi_.w << 16), b_[3] - __uint_as_float(hi_.w & 0xffff0000u)); \
                v2u w8_; w8_.x = pk4_fp8(a_[0], a_[1], a_[2], a_[3]); w8_.y = pk4_fp8(b_[0], b_[1], b_[2], b_[3]); \
                *(v2u*)((unsigned char*)h2b + (size_t)row_ * D + 8 * lane_ + 512 * j2) = w8_; \
                *(LAS v4u*)(AH + lr_ * ARS + (8 * lane_ + 512 * j2) * 2) = hi_; *(LAS v4u*)(AL + lr_ * ARS + (8 * lane_ + 512 * j2) * 2) = lo_; } } while (0)
        const int fr = lane & 15, fq = lane >> 4;
        for (int rb = bx; rb < T / 64; rb += G) {
            if (tid < 32) lcnt[tid] = 0;
            v4u raw[2][4];
#define ROUTER_FETCH(p_) do { _Pragma("unroll") for (int q = 0; q < 2; ++q) _Pragma("unroll") for (int j2 = 0; j2 < 4; ++j2) \
                raw[q][j2] = *(const v4u*)((const bf16*)pre2 + (size_t)(rb * 64 + (p_) * 16 + 2 * wave + q) * D + 8 * lane + 512 * j2); } while (0)
            ROUTER_FETCH(0);
#pragma nounroll
            for (int ps = 0; ps < 4; ++ps) {
                bf16x8 bh0[4][2], bl0[4][2];
                unsigned boff = (unsigned)((fr * D + 256 * wave + 8 * fq) * 2); asm volatile("" : "+v"(boff));
#pragma unroll
                for (int ks = 0; ks < 4; ++ks)
#pragma unroll
                    for (int nt = 0; nt < 2; ++nt) { bh0[ks][nt] = *(const bf16x8*)((const char*)(WSP(bf16, WS_WRH) + nt * 16 * D) + boff + 64 * ks); bl0[ks][nt] = *(const bf16x8*)((const char*)(WSP(bf16, WS_WRL) + nt * 16 * D) + boff + 64 * ks); }
                ROUTER_LN(ps, 0);
                ROUTER_LN(ps, 1);
                if (ps + 1 < 4) ROUTER_FETCH(ps + 1);
                __syncthreads();
                {   bf16x8 bh1[4][2], bl1[4][2];
#pragma unroll
                    for (int ks = 0; ks < 4; ++ks)
#pragma unroll
                        for (int nt = 0; nt < 2; ++nt) { bh1[ks][nt] = *(const bf16x8*)((const char*)(WSP(bf16, WS_WRH) + nt * 16 * D) + boff + 64 * (ks + 4)); bl1[ks][nt] = *(const bf16x8*)((const char*)(WSP(bf16, WS_WRL) + nt * 16 * D) + boff + 64 * (ks + 4)); }
                    f32x4 acc[2] = {{0.f, 0.f, 0.f, 0.f}, {0.f, 0.f, 0.f, 0.f}};
                    const LAS unsigned char* ah = AH + fr * ARS + (256 * wave + 8 * fq) * 2; const LAS unsigned char* al = AL + fr * ARS + (256 * wave + 8 * fq) * 2;
#pragma unroll
                    for (int ks = 0; ks < 4; ++ks) { const bf16x8 xh = *(const LAS bf16x8*)(ah + 64 * ks), xl = *(const LAS bf16x8*)(al + 64 * ks);
#pragma unroll
                        for (int nt = 0; nt < 2; ++nt) { acc[nt] = __builtin_amdgcn_mfma_f32_16x16x32_bf16(bl0[ks][nt], xh, acc[nt], 0, 0, 0); acc[nt] = __builtin_amdgcn_mfma_f32_16x16x32_bf16(bh0[ks][nt], xl, acc[nt], 0, 0, 0);
                            acc[nt] = __builtin_amdgcn_mfma_f32_16x16x32_bf16(bh0[ks][nt], xh, acc[nt], 0, 0, 0); } }
#pragma unroll
                    for (int ks = 0; ks < 4; ++ks) { const bf16x8 xh = *(const LAS bf16x8*)(ah + 64 * (ks + 4)), xl = *(const LAS bf16x8*)(al + 64 * (ks + 4));
#pragma unroll
                        for (int nt = 0; nt < 2; ++nt) { acc[nt] = __builtin_amdgcn_mfma_f32_16x16x32_bf16(bl1[ks][nt], xh, acc[nt], 0, 0, 0); acc[nt] = __builtin_amdgcn_mfma_f32_16x16x32_bf16(bh1[ks][nt], xl, acc[nt], 0, 0, 0);
                            acc[nt] = __builtin_amdgcn_mfma_f32_16x16x32_bf16(bh1[ks][nt], xh, acc[nt], 0, 0, 0); } }
                    *(LAS f32x4*)(PART + (wave * 16 + fr) * 32 + 4 * fq) = acc[0]; *(LAS f32x4*)(PART + (wave * 16 + fr) * 32 + 16 + 4 * fq) = acc[1];
                }
                __syncthreads();
                {   const int hs = lane >> 5, lr = 2 * wave + hs, rr = ps * 16 + lr, row = rb * 64 + rr, e = lane & 31;
                    float lg = b_router[e];
#pragma unroll
                    for (int w8 = 0; w8 < 8; ++w8) lg += PART[(w8 * 16 + lr) * 32 + e];
                    float tl[4]; int te[4]; float val = lg;
#pragma unroll
                    for (int k = 0; k < 4; ++k) { float m = val; m = fmaxf(m, __shfl_xor(m, 1)); m = fmaxf(m, __shfl_xor(m, 2)); m = fmaxf(m, __shfl_xor(m, 4)); m = fmaxf(m, __shfl_xor(m, 8)); m = fmaxf(m, __shfl_xor(m, 16));
                        const unsigned long long bal = __ballot(val == m); const unsigned b32 = hs ? (unsigned)(bal >> 32) : (unsigned)bal; const int bi = (int)__builtin_ctz(b32) & 31;
                        tl[k] = m; te[k] = bi; if (e == bi) val = -3.0e38f; }
                    const float e1 = __expf(tl[1] - tl[0]), e2 = __expf(tl[2] - tl[0]), e3 = __expf(tl[3] - tl[0]); const float inv = 1.0f / (1.0f + e1 + e2 + e3);
                    if (e < 4) { const int ex = e == 0 ? te[0] : (e == 1 ? te[1] : (e == 2 ? te[2] : te[3])); const float gt = (e == 0 ? 1.0f : (e == 1 ? e1 : (e == 2 ? e2 : e3))) * inv;
                        gates[(size_t)row * 4 + e] = gt; if (side) { const int sl = __hip_atomic_fetch_add(&lcnt[ex], 1, __ATOMIC_RELAXED, __HIP_MEMORY_SCOPE_WORKGROUP); lsel[rr * 4 + e] = ex | (sl << 8); } }
                }
            }
            __syncthreads();
            if (tid < 32 && side) lbase[tid] = (int)atomicAdd(&ecnt[tid], (unsigned)lcnt[tid]);
            __syncthreads();
            if (tid < 256 && side) { const int s_ = lsel[tid]; const int e = s_ & 255, sl = s_ >> 8; list[e * MOE_CAP + lbase[e] + sl] = (rb * 64 + (tid >> 2)) * 4 + (tid & 3); }
            __syncthreads();
        }
    }
#undef ROUTER_LN
#undef ROUTER_FETCH
    SEAM(13);
    if (IN(14) || IN(15)) {
        LAS int* tab = (LAS int*)(lds + MOETAB_OFF);
        if (tid == 0) { int ts = 0; for (int e = 0; e < 32; ++e) { const int c = (int)__hip_atomic_load(&ecnt[e], RLX_AGENT); tab[e] = ts; tab[33 + e] = c; ts += (c + 255) >> 8; } tab[32] = ts; }
        __syncthreads();
        if (IN(14)) {
            LAS unsigned short* toks = (LAS unsigned short*)(lds + RING_BYTES);
            {   pg8::SchedMoe S0{tab, nullptr, nullptr, list, 16, G, bx, 0, 1, nullptr}; pg8::Unit u0;
                for (int i = 0; i < 32 && S0.next(i, u0); ++i) if (tid < 256) { int a = 0; if (tid < u0.rows) a = list[u0.e * MOE_CAP + u0.mt * 256 + tid]; toks[i * 256 + tid] = (unsigned short)(a >> 2); }
                __syncthreads(); }
            pg8::SchedMoe S{tab, (const char*)h2b, (const char*)Wgu_t, list, 16, G, bx, (size_t)4096 * D, 1, G >= 160 ? toks : (LAS unsigned short*)nullptr};
            pg8::EpiSwiglu E{act, bgup, 1.0f / 256.0f};
            pg8::gemm_phase<pg8::EpiSwiglu, pg8::SchedMoe, true, 1>(lds, D, D, D, S, E);
        }
        SEAM(14);
        if (IN(15)) {
            LAS int* tA = (LAS int*)(lds + RING_BYTES); LAS float* tG = (LAS float*)(lds + RING_BYTES + 12 * 1024);
            const bool tok = G >= 216;
            if (tok) { pg8::SchedMoe S0{tab, nullptr, nullptr, list, 8, G, bx, 0, 1, nullptr}; pg8::Unit u0;
                for (int i = 0; i < 12 && S0.next(i, u0); ++i) if (tid < 256) { int a = -1; float g = 0.f; if (tid < u0.rows) { a = list[u0.e * MOE_CAP + u0.mt * 256 + tid]; g = gates[a]; } tA[i * 256 + tid] = a; tG[i * 256 + tid] = g; }
                __syncthreads(); }
            pg8::SchedMoe S{tab, (const char*)act, (const char*)Wd_t, nullptr, 8, G, bx, (size_t)D * D, 1, nullptr};
            pg8::EpiDown E{ybuf, b_down, list, gates, 1.0f / 256.0f, tok ? tA : (LAS int*)nullptr, tok ? tG : (LAS float*)nullptr};
            pg8::gemm_phase<pg8::EpiDown, pg8::SchedMoe, false, 1>(lds, D, D, D, S, E);
        }
    }
    SEAM(15);
    if (IN(16)) {
        v4u hw[4]; v2u yw[4][4]; f32x2 st2;
#define P16_FETCH(r_) do { _Pragma("unroll") for (int j2 = 0; j2 < 4; ++j2) { hw[j2] = *(const v4u*)((const bf16*)pre2 + (size_t)(r_) * D + 8 * lane + 512 * j2); \
            _Pragma("unroll") for (int k = 0; k < 4; ++k) yw[j2][k] = *(const v2u*)((const unsigned char*)ybuf + ((size_t)(r_) * 4 + k) * D + 8 * lane + 512 * j2); } \
            st2 = *(const f32x2*)(WSP(float, WS_ST2) + 2 * (size_t)(r_)); } while (0)
        if (gw < T) P16_FETCH(gw);
        for (int row = gw; row < T; row += NGW) {
            f32x4 v[8];
#pragma unroll
            for (int j2 = 0; j2 < 4; ++j2) { f32x4 a0, a1; bf16x8_to_f32(hw[j2], a0, a1);
                {
                    const f32x4 g0 = *(const f32x4*)(ln2_g + COLB(2 * j2)), g1 = *(const f32x4*)(ln2_g + COLB(2 * j2 + 1)), b0 = *(const f32x4*)(ln2_b + COLB(2 * j2)), b1 = *(const f32x4*)(ln2_b + COLB(2 * j2 + 1));
                    a0 = ((a0 - st2[0]) * st2[1] * g0 + b0) * ALPHA; a1 = ((a1 - st2[0]) * st2[1] * g1 + b1) * ALPHA; }
#pragma unroll
                for (int k = 0; k < 4; ++k) { const v2u w = yw[j2][k];
                    const f32x2 p0 = __builtin_amdgcn_cvt_pk_f32_fp8(w.x, false), p1 = __builtin_amdgcn_cvt_pk_f32_fp8(w.x, true), p2 = __builtin_amdgcn_cvt_pk_f32_fp8(w.y, false), p3 = __builtin_amdgcn_cvt_pk_f32_fp8(w.y, true);
                    a0 = a0 + (f32x4){p0[0], p0[1], p1[0], p1[1]} * 0.0625f; a1 = a1 + (f32x4){p2[0], p2[1], p3[0], p3[1]} * 0.0625f; }
                v[2 * j2] = a0; v[2 * j2 + 1] = a1; }
            if (row + NGW < T) P16_FETCH(row + NGW);
            ln_apply_b(v, ln3_g, ln3_b, lane);
#pragma unroll
            for (int j = 0; j < 8; ++j) __builtin_nontemporal_store(v[j], (f32x4*)(args.out + (size_t)row * D + COLB(j)));
        }
#undef P16_FETCH
    }
#undef IN
#undef SEAM
}
#undef x_in
#undef mem_in
#undef w_in
#undef b_in
#undef w_a2
#undef b_a
#undef gla_g
#undef hgrn_g
#undef lb_logits
#undef w_mix_o
#undef w_xq
#undef w_mem_kv
#undef w_xo
#undef w_router
#undef b_router
#undef w_gate_up
#undef b_gate_up
#undef w_down
#undef b_down
#undef ln1_g
#undef ln1_b
#undef ln2_g
#undef ln2_b
#undef ln3_g
#undef ln3_b
#undef Win_t
#undef Wo_t
#undef Wxq_t
#undef Wkv_t
#undef Wxo_t
#undef Wgu_t
#undef Wd_t
#undef xb
#undef memb
#undef ga1
#undef binc
#undef bgup
#undef lbt
#undef proj
#undef glog
#undef ogla
#undef oh
#undef merged
#undef pre1
#undef h1
#undef h1b
#undef qb
#undef kk
#undef vt
#undef sc
#undef Pb
#undef ao
#undef pre2
#undef h2
#undef h2b
#undef list
#undef gates
#undef act
#undef ybuf
#undef ecnt
#undef WSP
#undef ws_

extern "C" void kernel_launch(void* const* d_in, const int* in_sizes, int n_in, void* d_out, int out_size, void* d_ws, size_t ws_size, hipStream_t stream) {
    static int grid = 0;
    if (grid == 0) {
        if (n_in != 25 || out_size != T * D || ws_size < WS_END) { fprintf(stderr, "kernel_launch: unexpected problem: n_in %d out %d ws %zu (need %zu)\n", n_in, out_size, ws_size, (size_t)WS_END); grid = -1; return; }
        int dev = 0, cus = 0, per_cu = 0;
        if (hipGetDevice(&dev) != hipSuccess || hipDeviceGetAttribute(&cus, hipDeviceAttributeMultiprocessorCount, dev) != hipSuccess) { grid = -1; return; }
        if (hipFuncSetAttribute((const void*)fwd_kernel, hipFuncAttributeMaxDynamicSharedMemorySize, LDS_BYTES) != hipSuccess) { fprintf(stderr, "kernel_launch: hipFuncSetAttribute failed\n"); grid = -1; return; }
        if (hipOccupancyMaxActiveBlocksPerMultiprocessor(&per_cu, (const void*)fwd_kernel, NTHREADS, LDS_BYTES) != hipSuccess || per_cu < 1) { fprintf(stderr, "kernel_launch: occupancy query says %d\n", per_cu); }
        (void)hipGetLastError();
        grid = cus;
    }
    if (grid < 0) return;
    (void)hipMemsetAsync((char*)d_ws + WS_CTL, 0, CTL_ZERO_BYTES, stream);
    Args a{};
    for (int i = 0; i < 25; ++i) a.in[i] = (const float*)d_in[i];
    a.out = (float*)d_out; a.ws = (unsigned char*)d_ws;
#if MK_ONE_LAUNCH
    a.ph_lo = 0; a.ph_hi = N_PHASES;
    hipLaunchKernelGGL(fwd_kernel, dim3(grid), dim3(NTHREADS), LDS_BYTES, stream, a);
#ifdef PROBE_PHASE
    a.ph_lo = PROBE_PHASE; a.ph_hi = PROBE_PHASE + 1;
#ifdef PROBE_FLAGS
    a.flags = PROBE_FLAGS;
#endif
    hipLaunchKernelGGL(fwd_kernel, dim3(grid), dim3(NTHREADS), LDS_BYTES, stream, a);
#endif
#else
    for (int p = 0; p < N_PHASES; ++p) { a.ph_lo = p; a.ph_hi = p + 1; hipLaunchKernelGGL(fwd_kernel, dim3(grid), dim3(NTHREADS), LDS_BYTES, stream, a); }
#endif
}
```

```cpp
#include <hip/hip_runtime.h>
#include <cstdio>
#include <cstdint>

#ifndef MK_ONE_LAUNCH
#define MK_ONE_LAUNCH 1
#endif

#define GAS __attribute__((address_space(1)))
#define LAS __attribute__((address_space(3)))
typedef unsigned short bf16;
typedef unsigned v4u __attribute__((ext_vector_type(4)));
typedef unsigned v2u __attribute__((ext_vector_type(2)));
typedef float f32x4 __attribute__((ext_vector_type(4)));
typedef float f32x2 __attribute__((ext_vector_type(2)));
typedef short bf16x8 __attribute__((ext_vector_type(8)));
#define RLX_AGENT __ATOMIC_RELAXED, __HIP_MEMORY_SCOPE_AGENT
#define LDS_WAIT() asm volatile("s_waitcnt lgkmcnt(0)" ::: "memory")
#define VM_WAIT() asm volatile("s_waitcnt vmcnt(0)" ::: "memory")

constexpr int D = 2048, NBATCH = 2, SEQ = 8192, T = NBATCH * SEQ;
constexpr int DIN = 18448, NPROJ = 18432;
constexpr int GQ = 0, GK = 1024, GV = 2048, GR = 4096, HQ = 6144, HF = 8192, HI = 10240, HG = 12288, MA = 14336, MB = 16384;
constexpr int GA1_COL = 6144;
constexpr int NE = 32, TOPK = 4, NMEM = 256, XH = 4, XDH = 512;
constexpr int MOE_CAP = 16384, MOE_MAXTILES = 288;
constexpr float ALPHA = 1.189207115002721f;
constexpr float EPS = 1e-5f;
constexpr int NWAVES = 8, NTHREADS = 512;

#ifndef FP8_EXTRA
#define FP8_EXTRA 8, 9, 10, 11, 12, 13, 14, 15, 16, 17, 18, 19, 20, 21, 22, 23, 24, 25, 26, 27, 28, 29, 30, 31, 40, 41, 42, 43, 44, 45, 46, 47,
#endif
__device__ const unsigned char TILES_FP8[] = {FP8_EXTRA 32, 33, 34, 35, 36, 37, 38, 39, 48, 49, 50, 51, 52, 53, 54, 55, 56, 57, 58, 59, 60, 61, 62, 63, 64, 65, 66, 67, 68, 69, 70, 71};
constexpr int N_FP8_TILES = sizeof(TILES_FP8);
constexpr int N_BF16_TILES = 72 - N_FP8_TILES;
constexpr size_t MiB = 1u << 20;
constexpr size_t WS_CTL = 0, CTL_ZERO_BYTES = 1 * MiB;
constexpr size_t WS_WIN_T = 1 * MiB;
constexpr size_t WS_WO_T = WS_WIN_T + 72 * MiB;
constexpr size_t WS_WXQ_T = WS_WO_T + 8 * MiB;
constexpr size_t WS_WKV_T = WS_WXQ_T + 8 * MiB;
constexpr size_t WS_WXO_T = WS_WKV_T + 16 * MiB;
constexpr size_t WS_WGU_T = WS_WXO_T + 8 * MiB;
constexpr size_t WS_WD_T = WS_WGU_T + 512 * MiB;
constexpr size_t WS_XB = WS_WD_T + 256 * MiB;
constexpr size_t WS_MEMB = WS_XB + 64 * MiB;
constexpr size_t WS_GA1 = WS_MEMB + 2 * MiB;
constexpr size_t WS_BINC = WS_GA1 + 1 * MiB;
constexpr size_t WS_BGUP = WS_BINC + 1 * MiB;
constexpr size_t WS_LB = WS_BGUP + 1 * MiB;
constexpr size_t WS_PROJ = WS_LB + 1 * MiB;
constexpr size_t WS_GLOG = WS_PROJ + 576 * MiB;
constexpr size_t WS_OGLA = WS_GLOG + 64 * MiB;
constexpr size_t WS_OH = WS_OGLA + 128 * MiB;
constexpr size_t WS_MERGED = WS_OH + 128 * MiB;
constexpr size_t WS_PRE1 = WS_MERGED + 64 * MiB;
constexpr size_t WS_H1 = WS_PRE1 + 128 * MiB;
constexpr size_t WS_H1B = WS_H1 + 128 * MiB;
constexpr size_t WS_STAT = WS_H1 + 64 * MiB;
constexpr size_t WS_FST = WS_H1 + 72 * MiB;
constexpr size_t WS_WRH = WS_H1 + 88 * MiB;
constexpr size_t WS_WRL = WS_H1 + 89 * MiB;
constexpr size_t WS_ST2 = WS_H1 + 90 * MiB;
constexpr size_t WS_C12 = WS_H1 + 80 * MiB;
constexpr size_t WS_Q = WS_H1B + 64 * MiB;
constexpr size_t WS_KK = WS_Q + 64 * MiB;
constexpr size_t WS_VT = WS_KK + 2 * MiB;
constexpr size_t WS_SC = WS_VT + 2 * MiB;
constexpr size_t WS_P = WS_SC + 64 * MiB;
constexpr size_t WS_AO = WS_P + 32 * MiB;
constexpr size_t WS_PRE2 = WS_AO + 64 * MiB;
constexpr size_t WS_H2 = WS_PRE2 + 128 * MiB;
constexpr size_t WS_H2B = WS_H2 + 128 * MiB;
constexpr size_t WS_LIST = WS_H2B + 64 * MiB;
constexpr size_t WS_GATES = WS_LIST + 2 * MiB;
constexpr size_t WS_ACT = WS_GATES + 1 * MiB;
constexpr size_t WS_YBUF = WS_ACT + 288 * MiB;
constexpr size_t WS_QFG = WS_YBUF + 256 * MiB;
constexpr size_t WS_KFG = WS_QFG + 32 * MiB;
constexpr size_t WS_PFG = WS_KFG + 32 * MiB;
constexpr size_t WS_LAMG = WS_PFG + 6 * MiB;
constexpr size_t WS_VFG = WS_LAMG + 1 * MiB;
constexpr size_t WS_QFH = WS_VFG + 64 * MiB;
constexpr size_t WS_KFH = WS_QFH + 64 * MiB;
constexpr size_t WS_PFH = WS_KFH + 64 * MiB;
constexpr size_t WS_LAMH = WS_PFH + 24 * MiB;
constexpr size_t WS_VFH = WS_LAMH + 4 * MiB;
constexpr size_t WS_END = WS_VFH + 64 * MiB + 1 * MiB;
constexpr int CW_TMO = 0;
constexpr int CW_CNT = 64;
constexpr int CW_HQ = 256;
constexpr int CW_BAR = 4096;

constexpr int RING_BYTES = 131072;
constexpr int LDS_BYTES = 163840;
constexpr int MISC_OFF = LDS_BYTES - 1024;
constexpr int MOETAB_OFF = MISC_OFF + 256;
constexpr int SCAN_STAGE = 76800;
static_assert(2 * SCAN_STAGE <= MISC_OFF, "scan stages below the control words");

__device__ __forceinline__ float bf2f(unsigned b) { return __uint_as_float(b << 16); }
__device__ __forceinline__ unsigned f2bf(float f) { unsigned u = __float_as_uint(f); return (u + 0x7fffu + ((u >> 16) & 1u)) >> 16; }
typedef __bf16 bf16x2_hw __attribute__((ext_vector_type(2)));
__device__ __forceinline__ unsigned pk2(float lo, float hi) { f32x2 v = {lo, hi}; return __builtin_bit_cast(unsigned, __builtin_convertvector(v, bf16x2_hw)); }
__device__ __forceinline__ float sigmoidf_(float x) { return __builtin_amdgcn_rcpf(1.0f + __expf(-x)); }
__device__ __forceinline__ float logsigmoidf_(float z) { return z < 0.f ? z - log1pf(__expf(z)) : -log1pf(__expf(-z)); }
__device__ __forceinline__ float wave_sum(float v) {
#pragma unroll
    for (int o = 1; o < 64; o <<= 1) v += __shfl_xor(v, o);
    return v;
}
__device__ __forceinline__ float wave_max(float v) {
#pragma unroll
    for (int o = 1; o < 64; o <<= 1) v = fmaxf(v, __shfl_xor(v, o));
    return v;
}

namespace pg8 {
constexpr int BM = 256, BK = 64, HALF = 128, HTB = HALF * BK * 2, STAGE_BYTES = 8 * HTB, NXCD = 8, WGM = 8;
__host__ __device__ __forceinline__ int lds_byte(int r, int c) { const int st = (r >> 4) * 2 + (c >> 5), rr = r & 15, cc = c & 31, ob = rr * 64 + cc * 2; return st * 1024 + (ob ^ (((ob >> 9) & 1) << 5)); }
__host__ __device__ __forceinline__ void stage_rc(int b, int& R, int& C) { const int st = b / 1024, sb = b % 1024, swz = sb ^ (((sb >> 9) & 1) << 5); R = (st >> 1) * 16 + swz / 64; C = (st & 1) * 32 + (swz % 64) / 2; }
__host__ __device__ __forceinline__ int perm32(int rho) { const int n = rho >> 4, i = rho & 15; return 8 * (i >> 2) + 4 * n + (i & 3); }

struct Unit { int pm, pn, e, mt, rows, idx; };

__device__ __forceinline__ bool static_next(int nM, int nN, int G, int c, int i, Unit& u) {
    const int nwg = nM * nN; const long L = (long)i * G + c; if (L >= nwg) return false;
    int wgid = (int)L; { const int q = nwg / NXCD, r = nwg % NXCD, xcd = wgid % NXCD, off = wgid / NXCD; wgid = (xcd < r ? xcd * (q + 1) : r * (q + 1) + (xcd - r) * q) + off; }
    const int nig = WGM * nN, gid = wgid / nig, fm = gid * WGM, gsz = (nM - fm) < WGM ? (nM - fm) : WGM;
    u.pm = fm + ((wgid % nig) % gsz); u.pn = (wgid % nig) / gsz; u.e = 0; u.mt = 0; u.rows = 256; u.idx = i; return true;
}

__device__ __forceinline__ unsigned cvt_pk_bf16(float lo, float hi) { unsigned r; asm volatile("v_cvt_pk_bf16_f32 %0, %1, %2" : "=v"(r) : "v"(lo), "v"(hi)); return r; }

typedef f32x4 Acc[2][2][4][2];

typedef int i32x4_t __attribute__((ext_vector_type(4)));
typedef int i32x8_t __attribute__((ext_vector_type(8)));
__device__ __forceinline__ i32x8_t cat8(bf16x8 a, bf16x8 b) { return __builtin_shufflevector(__builtin_bit_cast(i32x4_t, a), __builtin_bit_cast(i32x4_t, b), 0, 1, 2, 3, 4, 5, 6, 7); }
template <class Epi, class Sched, bool GATHER, int ESZ = 2>
__device__ __forceinline__ void gemm_phase(LAS unsigned char* lds, const int K, const int lda, const int ldb, const Sched& S, const Epi& E) {
    int tid_ = threadIdx.x; asm volatile("" : "+v"(tid_));
    const int tid = tid_, wid = __builtin_amdgcn_readfirstlane(tid >> 6), lane = tid & 63, wr = wid >> 2, wc = wid & 3, fr = lane & 15, fq = lane >> 4;
    const int nt = K * ESZ / 128;
    unsigned voffA[2], voffB[2]; int RA[2]; unsigned CA2[2];
#pragma unroll
    for (int i = 0; i < 2; ++i) { int R, C; stage_rc(tid * 16 + i * 8192, R, C); const int Rb = Epi::PERM ? ((R & ~31) + perm32(R & 31)) : R;
        voffA[i] = (unsigned)(R * lda * ESZ + C * 2); voffB[i] = (unsigned)(Rb * ldb * ESZ + C * 2); RA[i] = R; CA2[i] = (unsigned)C * 2u; }
    const size_t kstep = (size_t)(BK * 2);
    const size_t hstepA = (size_t)HALF * lda * ESZ, hstepB = (size_t)HALF * ldb * ESZ;
    const unsigned ldsw = (unsigned)wid * 1024u;
    const int aoff = lds_byte(wr * 64 + fr, fq * 8), boff = lds_byte(wc * 32 + fr, fq * 8);
#define PG8_SA(b, h) (((b) * 2 + (h)) * HTB)
#define PG8_SB(b, h) ((4 + (b) * 2 + (h)) * HTB)
#define PG8_STAGE_RAW(bufoff, gptr, o0, o1) do { \
        __builtin_amdgcn_global_load_lds((const unsigned*)((const char*)(gptr) + (o0)), (LAS unsigned*)(lds + (bufoff) + ldsw), 16, 0, 0); \
        __builtin_amdgcn_global_load_lds((const unsigned*)((const char*)(gptr) + (o1)), (LAS unsigned*)(lds + (bufoff) + ldsw + 8192), 16, 0, 0); } while (0)
#define PG8_STAGE_B(bufoff, gptr) PG8_STAGE_RAW(bufoff, gptr, voffB[0], voffB[1])
#define PG8_STAGE_A_CUR(bufoff, kptr, half) do { if constexpr (GATHER) { if ((half) == 0) PG8_STAGE_RAW(bufoff, kptr, vAc0[0], vAc0[1]); else PG8_STAGE_RAW(bufoff, kptr, vAc1[0], vAc1[1]); } \
        else { PG8_STAGE_RAW(bufoff, (kptr) + (half) * hstepA, voffA[0], voffA[1]); } } while (0)
#define PG8_STAGE_A_SEL(bufoff, kptr, half) do { if constexpr (GATHER) { if ((half) == 0) PG8_STAGE_RAW(bufoff, kptr, (last ? vAn0[0] : vAc0[0]), (last ? vAn0[1] : vAc0[1])); else PG8_STAGE_RAW(bufoff, kptr, (last ? vAn1[0] : vAc1[0]), (last ? vAn1[1] : vAc1[1])); } \
        else { PG8_STAGE_RAW(bufoff, (kptr) + (half) * hstepA, voffA[0], voffA[1]); } } while (0)
#define PG8_LDA(dst, b, h) do { _Pragma("unroll") for (int m = 0; m < 4; ++m) { const i32x4_t lo_ = *(const LAS i32x4_t*)(lds + PG8_SA(b, h) + aoff + m * 2048), hi_ = *(const LAS i32x4_t*)(lds + PG8_SA(b, h) + aoff + m * 2048 + 1024); dst[m] = __builtin_shufflevector(lo_, hi_, 0, 1, 2, 3, 4, 5, 6, 7); } } while (0)
#define PG8_LDB(dst, b, h) do { _Pragma("unroll") for (int n = 0; n < 2; ++n) { const i32x4_t lo_ = *(const LAS i32x4_t*)(lds + PG8_SB(b, h) + boff + n * 2048), hi_ = *(const LAS i32x4_t*)(lds + PG8_SB(b, h) + boff + n * 2048 + 1024); dst[n] = __builtin_shufflevector(lo_, hi_, 0, 1, 2, 3, 4, 5, 6, 7); } } while (0)
#define PG8_LO(x) __builtin_bit_cast(bf16x8, __builtin_shufflevector(x, x, 0, 1, 2, 3))
#define PG8_HI(x) __builtin_bit_cast(bf16x8, __builtin_shufflevector(x, x, 4, 5, 6, 7))
#define PG8_MMA(ai, bj, At, Bt) do { __builtin_amdgcn_s_setprio(1); if constexpr (ESZ == 2) { _Pragma("unroll") for (int m = 0; m < 4; ++m) _Pragma("unroll") for (int n = 0; n < 2; ++n) { \
        acc[ai][bj][m][n] = __builtin_amdgcn_mfma_f32_16x16x32_bf16(PG8_LO(Bt[n]), PG8_LO(At[m]), acc[ai][bj][m][n], 0, 0, 0); acc[ai][bj][m][n] = __builtin_amdgcn_mfma_f32_16x16x32_bf16(PG8_HI(Bt[n]), PG8_HI(At[m]), acc[ai][bj][m][n], 0, 0, 0); } } \
        else { _Pragma("unroll") for (int m = 0; m < 4; ++m) _Pragma("unroll") for (int n = 0; n < 2; ++n) \
        asm volatile("v_mfma_scale_f32_16x16x128_f8f6f4 %0, %1, %2, %0, %3, %3 op_sel_hi:[0,0,0]" : "+v"(acc[ai][bj][m][n]) : "v"(Bt[n]), "v"(At[m]), "v"(mx_one)); } __builtin_amdgcn_s_setprio(0); } while (0)
#define PG8_WAIT_V(n) asm volatile("s_waitcnt vmcnt(" #n ")" ::: "memory")
#define PG8_WAIT_L(n) asm volatile("s_waitcnt lgkmcnt(" #n ")" ::: "memory")
#define PG8_BAR __builtin_amdgcn_s_barrier()
#define PG8_SCHED __builtin_amdgcn_sched_barrier(0)
    Unit cur, nxt; int ui = 0;
    if (!S.next(0, cur)) return;
    Acc acc;
#pragma unroll
    for (int a = 0; a < 2; ++a)
#pragma unroll
        for (int b = 0; b < 2; ++b)
#pragma unroll
            for (int m = 0; m < 4; ++m)
#pragma unroll
                for (int n = 0; n < 2; ++n) acc[a][b][m][n] = (f32x4){0.f, 0.f, 0.f, 0.f};
    i32x8_t At[4], B0[2], B1[2];
    const int mx_one = 0x7F7F7F7F;
    const char* cA = S.a_base(cur); const char* cB = S.b_base(cur);
    unsigned vAc0[2] = {0u, 0u}, vAc1[2] = {0u, 0u}, vAn0[2] = {0u, 0u}, vAn1[2] = {0u, 0u};
    if constexpr (GATHER) {
#pragma unroll
        for (int i = 0; i < 2; ++i) { vAc0[i] = S.row_off(cur, RA[i]) + CA2[i]; vAc1[i] = S.row_off(cur, HALF + RA[i]) + CA2[i]; }
    }
    PG8_STAGE_B(PG8_SB(0, 0), cB); PG8_STAGE_B(PG8_SB(0, 1), cB + hstepB); PG8_STAGE_A_CUR(PG8_SA(0, 0), cA, 0); PG8_STAGE_A_CUR(PG8_SA(0, 1), cA, 1);
    if (wr == 1) PG8_BAR;
    PG8_WAIT_V(2); PG8_BAR;
    PG8_STAGE_B(PG8_SB(1, 0), cB + kstep); PG8_STAGE_A_CUR(PG8_SA(1, 0), cA + kstep, 0); PG8_STAGE_B(PG8_SB(1, 1), cB + hstepB + kstep);
    PG8_WAIT_V(6); PG8_BAR;
    for (;;) {
        const bool has_next = S.next(ui + 1, nxt);
        const char* nA = has_next ? S.a_base(nxt) : cA; const char* nB = has_next ? S.b_base(nxt) : cB;
        if constexpr (GATHER) {
            if (has_next) {
#pragma unroll
                for (int i = 0; i < 2; ++i) { vAn0[i] = S.row_off(nxt, RA[i]) + CA2[i]; vAn1[i] = S.row_off(nxt, HALF + RA[i]) + CA2[i]; }
            } else {
#pragma unroll
                for (int i = 0; i < 2; ++i) { vAn0[i] = vAc0[i]; vAn1[i] = vAc1[i]; }
            }
        }
#pragma nounroll
        for (int t = 0; t < nt; t += 2) {
            const bool last = (t == nt - 2);
            const char* a1 = cA + (size_t)(t + 1) * kstep;
            const char* a2 = last ? nA : cA + (size_t)(t + 2) * kstep; const char* b2 = last ? nB : cB + (size_t)(t + 2) * kstep;
            const char* a3 = a2 + kstep; const char* b3 = b2 + kstep;
            PG8_LDB(B0, 0, 0); PG8_LDB(B1, 0, 1); PG8_SCHED; PG8_LDA(At, 0, 0); PG8_STAGE_A_CUR(PG8_SA(1, 1), a1, 1);
            PG8_WAIT_V(8); PG8_WAIT_L(0); PG8_BAR; PG8_MMA(0, 0, At, B0); PG8_MMA(0, 1, At, B1); PG8_BAR; PG8_SCHED;
            PG8_LDA(At, 0, 1); PG8_STAGE_B(PG8_SB(0, 0), b2); PG8_STAGE_B(PG8_SB(0, 1), b2 + hstepB); PG8_STAGE_A_SEL(PG8_SA(0, 0), a2, 0);
            PG8_WAIT_V(8); PG8_WAIT_L(0); PG8_BAR; if (!(Sched::HALF_SKIP && cur.rows <= HALF)) { PG8_MMA(1, 0, At, B0); PG8_MMA(1, 1, At, B1); } PG8_BAR; PG8_SCHED;
            PG8_LDB(B0, 1, 0); PG8_LDB(B1, 1, 1); PG8_SCHED; PG8_LDA(At, 1, 0); PG8_STAGE_A_SEL(PG8_SA(0, 1), a2, 1);
            PG8_WAIT_V(8); PG8_WAIT_L(0); PG8_BAR; PG8_MMA(0, 0, At, B0); PG8_MMA(0, 1, At, B1); PG8_BAR; PG8_SCHED;
            PG8_LDA(At, 1, 1); PG8_STAGE_B(PG8_SB(1, 0), b3); PG8_STAGE_B(PG8_SB(1, 1), b3 + hstepB); PG8_STAGE_A_SEL(PG8_SA(1, 0), a3, 0);
            PG8_WAIT_V(8); PG8_WAIT_L(0); PG8_BAR; if (!(Sched::HALF_SKIP && cur.rows <= HALF)) { PG8_MMA(1, 0, At, B0); PG8_MMA(1, 1, At, B1); } PG8_BAR; PG8_SCHED;
        }
        if (wr == 0) PG8_BAR;
        if constexpr (ESZ == 1) asm volatile("s_nop 15\n\ts_nop 15" ::: "memory");
        E(acc, cur, wr, wc, fr, fq);
        if (!has_next) break;
#pragma unroll
        for (int a = 0; a < 2; ++a)
#pragma unroll
            for (int b = 0; b < 2; ++b)
#pragma unroll
                for (int m = 0; m < 4; ++m)
#pragma unroll
                    for (int n = 0; n < 2; ++n) acc[a][b][m][n] = (f32x4){0.f, 0.f, 0.f, 0.f};
        cur = nxt; cA = nA; cB = nB; ++ui;
        if constexpr (GATHER) {
#pragma unroll
            for (int i = 0; i < 2; ++i) { vAc0[i] = vAn0[i]; vAc1[i] = vAn1[i]; }
        }
        if (wr == 1) PG8_BAR;
    }
    PG8_WAIT_V(0);
    PG8_BAR;
#undef PG8_SA
#undef PG8_SB
#undef PG8_STAGE_RAW
#undef PG8_STAGE_B
#undef PG8_STAGE_A_CUR
#undef PG8_STAGE_A_SEL
#undef PG8_LDA
#undef PG8_LDB
#undef PG8_MMA
#undef PG8_LO
#undef PG8_HI
#undef PG8_WAIT_V
#undef PG8_WAIT_L
#undef PG8_BAR
#undef PG8_SCHED
}

struct SchedDense {
    static constexpr bool HALF_SKIP = false;
    const char* A; const char* Bt; int nM, nN, G, c; size_t astep, bstep;
    __device__ __forceinline__ bool next(int i, Unit& u) const { return static_next(nM, nN, G, c, i, u); }
    __device__ __forceinline__ const char* a_base(const Unit& u) const { return A + (size_t)u.pm * astep; }
    __device__ __forceinline__ const char* b_base(const Unit& u) const { return Bt + (size_t)u.pn * bstep; }
    __device__ __forceinline__ unsigned row_off(const Unit&, int) const { return 0u; }
};
struct SchedSel {
    static constexpr bool HALF_SKIP = false;
    const char* A; const char* Bt; int nM, nSel, G, c; size_t astep, bstep; int fp8;
    __device__ __forceinline__ bool next(int i, Unit& u) const { if (!static_next(nM, nSel, G, c, i, u)) return false; u.e = u.pn;
        if (fp8) u.pn = TILES_FP8[u.e];
        else { int t = 0, k = -1; for (; t < 72; ++t) { bool in = false; for (int q = 0; q < N_FP8_TILES; ++q) in |= (TILES_FP8[q] == t); if (!in && ++k == u.e) break; } u.pn = t; }
        return true; }
    __device__ __forceinline__ const char* a_base(const Unit& u) const { return A + (size_t)u.pm * astep; }
    __device__ __forceinline__ const char* b_base(const Unit& u) const { return Bt + (size_t)(fp8 ? u.e : u.pn) * bstep; }
    __device__ __forceinline__ unsigned row_off(const Unit&, int) const { return 0u; }
};
struct SchedKV {
    static constexpr bool HALF_SKIP = false;
    const char* memb; const char* wkv; int G, c;
    __device__ __forceinline__ bool next(int i, Unit& u) const {
        const int L = i * G + c; if (L >= 32) return false;
        if (L < 16) { u.e = 0; u.pm = L & 1; u.pn = L >> 1; } else { const int l = L - 16; u.e = 1; u.pm = l >> 1; u.pn = l & 1; }
        u.mt = 0; u.rows = 256; u.idx = i; return true; }
    __device__ __forceinline__ const char* a_base(const Unit& u) const { return u.e == 0 ? memb + (size_t)u.pm * 256 * D * 2 : wkv + (size_t)(2048 + u.pm * 256) * D * 2; }
    __device__ __forceinline__ const char* b_base(const Unit& u) const { return u.e == 0 ? wkv + (size_t)u.pn * 256 * D * 2 : memb + (size_t)u.pn * 256 * D * 2; }
    __device__ __forceinline__ unsigned row_off(const Unit&, int) const { return 0u; }
};
struct SchedScores {
    static constexpr bool HALF_SKIP = false;
    const char* q; const char* kk; int G, c;
    __device__ __forceinline__ bool next(int i, Unit& u) const { return static_next(T / 256, XH, G, c, i, u); }
    __device__ __forceinline__ const char* a_base(const Unit& u) const { return q + ((size_t)u.pm * 256 * D + (size_t)u.pn * XDH) * 2; }
    __device__ __forceinline__ const char* b_base(const Unit& u) const { return kk + ((size_t)(u.pm / 32) * NMEM * D + (size_t)u.pn * XDH) * 2; }
    __device__ __forceinline__ unsigned row_off(const Unit&, int) const { return 0u; }
};
struct SchedPV {
    static constexpr bool HALF_SKIP = false;
    const char* P; const char* vt; int G, c;
    __device__ __forceinline__ bool next(int i, Unit& u) const { return static_next(T / 256, D / 256, G, c, i, u); }
    __device__ __forceinline__ const char* a_base(const Unit& u) const { return P + ((size_t)u.pm * 256 * 1024 + (size_t)(u.pn >> 1) * 256) * 2; }
    __device__ __forceinline__ const char* b_base(const Unit& u) const { return vt + ((size_t)u.pn * 256 * 512 + (size_t)(u.pm / 32) * NMEM) * 2; }
    __device__ __forceinline__ unsigned row_off(const Unit&, int) const { return 0u; }
};
template <class Base> struct SchedOwn : Base {
    int opm, opn0, on;
    __device__ __forceinline__ bool next(int i, Unit& u) const { if (i >= on) return false; u.pm = opm; u.pn = opn0 + i; u.e = 0; u.mt = 0; u.rows = 256; u.idx = i; return true; }
};
struct SchedMoe {
    static constexpr bool HALF_SKIP = true;
    const LAS int* tab; const char* A; const char* Bt; const int* list; int nN, G, c; size_t b_estride; int esz; const LAS unsigned short* toks;
    __device__ __forceinline__ int tb(int i) const { return __builtin_amdgcn_readfirstlane(tab[i]); }
    __device__ __forceinline__ bool next(int i, Unit& u) const {
        const int TM = tb(32), nwg = TM * nN; const long L = (long)i * G + c; if (L >= nwg) return false;
        int wgid = (int)L; { const int q = nwg / NXCD, r = nwg % NXCD, xcd = wgid % NXCD, off = wgid / NXCD; wgid = (xcd < r ? xcd * (q + 1) : r * (q + 1) + (xcd - r) * q) + off; }
        int lo = 0, hi = 31;
        while (lo < hi) { const int mid = (lo + hi) >> 1; if (wgid < tb(mid + 1) * nN) hi = mid; else lo = mid + 1; }
        const int e = lo, ts = tb(e), te = tb(e + 1) - ts, idx = wgid - ts * nN, cnt = tb(33 + e);
        u.e = e; u.pn = idx / te; u.mt = idx % te; u.pm = ts + u.mt; const int rem = cnt - u.mt * 256; u.rows = rem < 256 ? rem : 256; u.idx = i; return true; }
    __device__ __forceinline__ const char* a_base(const Unit& u) const { return A + (list ? (size_t)0 : (size_t)u.pm * 256 * D * esz); }
    __device__ __forceinline__ const char* b_base(const Unit& u) const { return Bt + (size_t)u.e * b_estride + (size_t)u.pn * 256 * D * esz; }
    __device__ __forceinline__ unsigned row_off(const Unit& u, int r) const {
        if (toks) return (unsigned)toks[u.idx * 256 + r] * (unsigned)(D * esz);
        int a = 0; if (r < u.rows) a = list[u.e * MOE_CAP + u.mt * 256 + r];
        return (unsigned)(a >> 2) * (unsigned)(D * esz); }
};

struct EpiBf16G {
    static constexpr bool PERM = true;
    bf16* O; int ldc; const float* bias; float scale; float ascale;
    __device__ __forceinline__ void operator()(const Acc& acc, const Unit& u, int wr, int wc, int fr, int fq) const {
        const int row0 = u.pm * BM + wr * 64 + fr, col0 = u.pn * BM + wc * 32 + 8 * fq;
        f32x4 bv[2][2];
#pragma unroll
        for (int bj = 0; bj < 2; ++bj)
#pragma unroll
            for (int n = 0; n < 2; ++n) bv[bj][n] = bias ? *(const f32x4*)(bias + col0 + bj * HALF + 4 * n) : (f32x4){0.f, 0.f, 0.f, 0.f};
#pragma unroll
        for (int ai = 0; ai < 2; ++ai)
#pragma unroll
            for (int m = 0; m < 4; ++m) { bf16* rowp = O + (size_t)(row0 + ai * HALF + m * 16) * ldc + col0;
#pragma unroll
                for (int bj = 0; bj < 2; ++bj) { f32x4 v0 = (acc[ai][bj][m][0] * ascale + bv[bj][0]) * scale, v1 = (acc[ai][bj][m][1] * ascale + bv[bj][1]) * scale;
                    v4u w; w.x = cvt_pk_bf16(v0[0], v0[1]); w.y = cvt_pk_bf16(v0[2], v0[3]); w.z = cvt_pk_bf16(v1[0], v1[1]); w.w = cvt_pk_bf16(v1[2], v1[3]);
                    *(v4u*)(rowp + bj * HALF) = w; } }
    }
};
struct EpiKV {
    static constexpr bool PERM = true;
    bf16* kk; bf16* vt;
    __device__ __forceinline__ void operator()(const Acc& acc, const Unit& u, int wr, int wc, int fr, int fq) const {
        bf16* O = u.e == 0 ? kk : vt; const int ldc = u.e == 0 ? D : 512;
        const int row0 = u.pm * BM + wr * 64 + fr, col0 = u.pn * BM + wc * 32 + 8 * fq;
#pragma unroll
        for (int ai = 0; ai < 2; ++ai)
#pragma unroll
            for (int m = 0; m < 4; ++m) { bf16* rowp = O + (size_t)(row0 + ai * HALF + m * 16) * ldc + col0;
#pragma unroll
                for (int bj = 0; bj < 2; ++bj) { const f32x4 v0 = acc[ai][bj][m][0], v1 = acc[ai][bj][m][1];
                    v4u w; w.x = cvt_pk_bf16(v0[0], v0[1]); w.y = cvt_pk_bf16(v0[2], v0[3]); w.z = cvt_pk_bf16(v1[0], v1[1]); w.w = cvt_pk_bf16(v1[2], v1[3]);
                    *(v4u*)(rowp + bj * HALF) = w; } }
    }
};
struct EpiF32Res {
    static constexpr bool PERM = false;
    float* C; int ldc; const float* res; float rs;
    __device__ __forceinline__ void operator()(const Acc& acc, const Unit& u, int wr, int wc, int fr, int fq) const {
        const int row0 = u.pm * BM + wr * 64 + fr, col0 = u.pn * BM + wc * 32 + 4 * fq;
#pragma unroll
        for (int ai = 0; ai < 2; ++ai)
#pragma unroll
            for (int m = 0; m < 4; ++m) { const size_t ro = (size_t)(row0 + ai * HALF + m * 16) * ldc + col0;
#pragma unroll
                for (int bj = 0; bj < 2; ++bj)
#pragma unroll
                    for (int n = 0; n < 2; ++n) { f32x4 v = acc[ai][bj][m][n]; if (res) v = v + rs * *(const f32x4*)(res + ro + bj * HALF + n * 16); *(f32x4*)(C + ro + bj * HALF + n * 16) = v; } }
    }
};
struct EpiFp8 {
    static constexpr bool PERM = true;
    unsigned char* O; int ldc; float scale;
    __device__ __forceinline__ void operator()(const Acc& acc, const Unit& u, int wr, int wc, int fr, int fq) const {
        const int row0 = u.pm * BM + wr * 64 + fr, col0 = u.pn * BM + wc * 32 + 8 * fq;
#pragma unroll
        for (int ai = 0; ai < 2; ++ai)
#pragma unroll
            for (int m = 0; m < 4; ++m) { unsigned char* rowp = O + (size_t)(row0 + ai * HALF + m * 16) * ldc + col0;
#pragma unroll
                for (int bj = 0; bj < 2; ++bj) { const f32x4 v0 = acc[ai][bj][m][0] * scale, v1 = acc[ai][bj][m][1] * scale; v2u w;
                    { unsigned t = 0u; t = __builtin_amdgcn_cvt_pk_fp8_f32(v0[0], v0[1], t, false); t = __builtin_amdgcn_cvt_pk_fp8_f32(v0[2], v0[3], t, true); w.x = t; t = 0u; t = __builtin_amdgcn_cvt_pk_fp8_f32(v1[0], v1[1], t, false); t = __builtin_amdgcn_cvt_pk_fp8_f32(v1[2], v1[3], t, true); w.y = t; }
                    *(v2u*)(rowp + bj * HALF) = w; } }
    }
};
struct EpiBf16Res {
    static constexpr bool PERM = true;
    bf16* O; int ldc; const float* resf; const bf16* resb; float rs; float ascale;
    __device__ __forceinline__ void operator()(const Acc& acc, const Unit& u, int wr, int wc, int fr, int fq) const {
        const int row0 = u.pm * BM + wr * 64 + fr, col0 = u.pn * BM + wc * 32 + 8 * fq;
#pragma unroll
        for (int ai = 0; ai < 2; ++ai)
#pragma unroll
            for (int m = 0; m < 4; ++m) { const size_t ro = (size_t)(row0 + ai * HALF + m * 16) * ldc + col0;
#pragma unroll
                for (int bj = 0; bj < 2; ++bj) { f32x4 r0, r1;
                    if (resf) { r0 = *(const f32x4*)(resf + ro + bj * HALF); r1 = *(const f32x4*)(resf + ro + bj * HALF + 4); }
                    else { const v4u w = *(const v4u*)(resb + ro + bj * HALF); r0 = (f32x4){__uint_as_float(w.x << 16), __uint_as_float(w.x & 0xffff0000u), __uint_as_float(w.y << 16), __uint_as_float(w.y & 0xffff0000u)};
                        r1 = (f32x4){__uint_as_float(w.z << 16), __uint_as_float(w.z & 0xffff0000u), __uint_as_float(w.w << 16), __uint_as_float(w.w & 0xffff0000u)}; }
                    const f32x4 v0 = acc[ai][bj][m][0] * ascale + rs * r0, v1 = acc[ai][bj][m][1] * ascale + rs * r1;
                    v4u w; w.x = cvt_pk_bf16(v0[0], v0[1]); w.y = cvt_pk_bf16(v0[2], v0[3]); w.z = cvt_pk_bf16(v1[0], v1[1]); w.w = cvt_pk_bf16(v1[2], v1[3]);
                    *(v4u*)(O + ro + bj * HALF) = w; } }
    }
};
struct EpiPre1 {
    static constexpr bool PERM = true;
    bf16* O; unsigned char* O8; int ldc; const float* resf; float rs; float* stats;
    __device__ __forceinline__ void operator()(const Acc& acc, const Unit& u, int wr, int wc, int fr, int fq) const {
        const int row0 = u.pm * BM + wr * 64 + fr, col0 = u.pn * BM + wc * 32 + 8 * fq;
#pragma unroll
        for (int ai = 0; ai < 2; ++ai)
#pragma unroll
            for (int m = 0; m < 4; ++m) { const int row = row0 + ai * HALF + m * 16; const size_t ro = (size_t)row * ldc + col0; float s1 = 0.f, s2 = 0.f;
#pragma unroll
                for (int bj = 0; bj < 2; ++bj) { const f32x4 r0 = *(const f32x4*)(resf + ro + bj * HALF), r1 = *(const f32x4*)(resf + ro + bj * HALF + 4);
                    const f32x4 v0 = acc[ai][bj][m][0] + rs * r0, v1 = acc[ai][bj][m][1] + rs * r1;
                    s1 += ((v0[0] + v0[1]) + (v0[2] + v0[3])) + ((v1[0] + v1[1]) + (v1[2] + v1[3]));
                    s2 += ((v0[0] * v0[0] + v0[1] * v0[1]) + (v0[2] * v0[2] + v0[3] * v0[3])) + ((v1[0] * v1[0] + v1[1] * v1[1]) + (v1[2] * v1[2] + v1[3] * v1[3]));
                    v4u w; w.x = cvt_pk_bf16(v0[0], v0[1]); w.y = cvt_pk_bf16(v0[2], v0[3]); w.z = cvt_pk_bf16(v1[0], v1[1]); w.w = cvt_pk_bf16(v1[2], v1[3]);
                    *(v4u*)(O + ro + bj * HALF) = w;
                    v2u w8; { unsigned t = 0u; t = __builtin_amdgcn_cvt_pk_fp8_f32(v0[0], v0[1], t, false); t = __builtin_amdgcn_cvt_pk_fp8_f32(v0[2], v0[3], t, true); w8.x = t; t = 0u; t = __builtin_amdgcn_cvt_pk_fp8_f32(v1[0], v1[1], t, false); t = __builtin_amdgcn_cvt_pk_fp8_f32(v1[2], v1[3], t, true); w8.y = t; }
                    *(v2u*)(O8 + ro + bj * HALF) = w8; }
                s1 += __shfl_xor(s1, 16); s1 += __shfl_xor(s1, 32); s2 += __shfl_xor(s2, 16); s2 += __shfl_xor(s2, 32);
                if (fq == 0) *(f32x2*)(stats + ((size_t)row * 32 + u.pn * 4 + wc) * 2) = (f32x2){s1, s2}; }
    }
};
struct EpiQFold {
    static constexpr bool PERM = true;
    bf16* O; int ldc; const float* stats; const float* c1; const float* c2; float scale; float ascale;
    __device__ __forceinline__ void operator()(const Acc& acc, const Unit& u, int wr, int wc, int fr, int fq) const {
        const int row0 = u.pm * BM + wr * 64 + fr, col0 = u.pn * BM + wc * 32 + 8 * fq;
#pragma unroll
        for (int bj = 0; bj < 2; ++bj) {
            const f32x4 a10 = *(const f32x4*)(c1 + col0 + bj * HALF), a11 = *(const f32x4*)(c1 + col0 + bj * HALF + 4), a20 = *(const f32x4*)(c2 + col0 + bj * HALF), a21 = *(const f32x4*)(c2 + col0 + bj * HALF + 4);
#pragma unroll
            for (int ai = 0; ai < 2; ++ai)
#pragma unroll
                for (int m = 0; m < 4; ++m) { const int row = row0 + ai * HALF + m * 16; const f32x2 st = *(const f32x2*)(stats + 2 * (size_t)row); const float mu = st[0], rstd = st[1];
                    const f32x4 v0 = ((acc[ai][bj][m][0] * ascale - mu * a10) * rstd + a20) * scale, v1 = ((acc[ai][bj][m][1] * ascale - mu * a11) * rstd + a21) * scale;
                    v4u w; w.x = cvt_pk_bf16(v0[0], v0[1]); w.y = cvt_pk_bf16(v0[2], v0[3]); w.z = cvt_pk_bf16(v1[0], v1[1]); w.w = cvt_pk_bf16(v1[2], v1[3]);
                    *(v4u*)(O + (size_t)row * ldc + col0 + bj * HALF) = w; } }
    }
};
struct EpiXoFold {
    static constexpr bool PERM = true;
    bf16* O; int ldc; const bf16* pre; const float* stats; const float* g; const float* b; float rs; float ascale;
    __device__ __forceinline__ void operator()(const Acc& acc, const Unit& u, int wr, int wc, int fr, int fq) const {
        const int row0 = u.pm * BM + wr * 64 + fr, col0 = u.pn * BM + wc * 32 + 8 * fq;
#pragma unroll
        for (int bj = 0; bj < 2; ++bj) {
            const f32x4 g0 = *(const f32x4*)(g + col0 + bj * HALF), g1 = *(const f32x4*)(g + col0 + bj * HALF + 4), b0 = *(const f32x4*)(b + col0 + bj * HALF), b1 = *(const f32x4*)(b + col0 + bj * HALF + 4);
#pragma unroll
            for (int ai = 0; ai < 2; ++ai)
#pragma unroll
                for (int m = 0; m < 4; ++m) { const int row = row0 + ai * HALF + m * 16; const size_t ro = (size_t)row * ldc + col0 + bj * HALF; const f32x2 st = *(const f32x2*)(stats + 2 * (size_t)row); const float mu = st[0], rstd = st[1];
                    const v4u pw = *(const v4u*)(pre + ro);
                    const f32x4 p0 = (f32x4){__uint_as_float(pw.x << 16), __uint_as_float(pw.x & 0xffff0000u), __uint_as_float(pw.y << 16), __uint_as_float(pw.y & 0xffff0000u)};
                    const f32x4 p1 = (f32x4){__uint_as_float(pw.z << 16), __uint_as_float(pw.z & 0xffff0000u), __uint_as_float(pw.w << 16), __uint_as_float(pw.w & 0xffff0000u)};
                    const f32x4 h0 = (p0 - mu) * rstd * g0 + b0, h1_ = (p1 - mu) * rstd * g1 + b1;
                    const f32x4 v0 = acc[ai][bj][m][0] * ascale + rs * h0, v1 = acc[ai][bj][m][1] * ascale + rs * h1_;
                    v4u w; w.x = cvt_pk_bf16(v0[0], v0[1]); w.y = cvt_pk_bf16(v0[2], v0[3]); w.z = cvt_pk_bf16(v1[0], v1[1]); w.w = cvt_pk_bf16(v1[2], v1[3]);
                    *(v4u*)(O + ro) = w; } }
    }
};
struct EpiSoftmax {
    static constexpr bool PERM = true;
    bf16* P; int ldc; LAS float* red;
    __device__ __forceinline__ void operator()(Acc& acc, const Unit& u, int wr, int wc, int fr, int fq) const {
        LAS float* RM = red + wr * 512; LAS float* RS = red + 1024 + wr * 512;
#pragma unroll
        for (int ai = 0; ai < 2; ++ai)
#pragma unroll
            for (int m = 0; m < 4; ++m) { float mx = -3.0e38f;
#pragma unroll
                for (int bj = 0; bj < 2; ++bj)
#pragma unroll
                    for (int n = 0; n < 2; ++n) { const f32x4 v = acc[ai][bj][m][n]; mx = fmaxf(mx, fmaxf(fmaxf(v[0], v[1]), fmaxf(v[2], v[3]))); }
                mx = fmaxf(mx, __shfl_xor(mx, 16)); mx = fmaxf(mx, __shfl_xor(mx, 32));
                if (fq == 0) RM[(ai * 64 + m * 16 + fr) * 4 + wc] = mx; }
        asm volatile("s_waitcnt lgkmcnt(0)" ::: "memory"); __builtin_amdgcn_s_barrier(); asm volatile("" ::: "memory");
#pragma unroll
        for (int ai = 0; ai < 2; ++ai)
#pragma unroll
            for (int m = 0; m < 4; ++m) { const f32x4 pm = *(const LAS f32x4*)(RM + (ai * 64 + m * 16 + fr) * 4); const float mx = fmaxf(fmaxf(pm[0], pm[1]), fmaxf(pm[2], pm[3])); float sm = 0.f;
#pragma unroll
                for (int bj = 0; bj < 2; ++bj)
#pragma unroll
                    for (int n = 0; n < 2; ++n) { f32x4 v = acc[ai][bj][m][n]; v[0] = __expf(v[0] - mx); v[1] = __expf(v[1] - mx); v[2] = __expf(v[2] - mx); v[3] = __expf(v[3] - mx); acc[ai][bj][m][n] = v; sm += (v[0] + v[1]) + (v[2] + v[3]); }
                sm += __shfl_xor(sm, 16); sm += __shfl_xor(sm, 32);
                if (fq == 0) RS[(ai * 64 + m * 16 + fr) * 4 + wc] = sm; }
        asm volatile("s_waitcnt lgkmcnt(0)" ::: "memory"); __builtin_amdgcn_s_barrier(); asm volatile("" ::: "memory");
        const int row0 = u.pm * BM + wr * 64 + fr, col0 = u.pn * BM + wc * 32 + 8 * fq;
#pragma unroll
        for (int ai = 0; ai < 2; ++ai)
#pragma unroll
            for (int m = 0; m < 4; ++m) { const f32x4 ps = *(const LAS f32x4*)(RS + (ai * 64 + m * 16 + fr) * 4); const float inv = __builtin_amdgcn_rcpf((ps[0] + ps[1]) + (ps[2] + ps[3]));
                bf16* rowp = P + (size_t)(row0 + ai * HALF + m * 16) * ldc + col0;
#pragma unroll
                for (int bj = 0; bj < 2; ++bj) { const f32x4 v0 = acc[ai][bj][m][0] * inv, v1 = acc[ai][bj][m][1] * inv;
                    v4u w; w.x = cvt_pk_bf16(v0[0], v0[1]); w.y = cvt_pk_bf16(v0[2], v0[3]); w.z = cvt_pk_bf16(v1[0], v1[1]); w.w = cvt_pk_bf16(v1[2], v1[3]);
                    *(v4u*)(rowp + bj * HALF) = w; } }
        asm volatile("s_waitcnt lgkmcnt(0)" ::: "memory"); __builtin_amdgcn_s_barrier(); asm volatile("" ::: "memory");
    }
};
struct EpiSwiglu {
    static constexpr bool PERM = true;
    bf16* act; const float* bias; float ws;
    __device__ __forceinline__ void operator()(const Acc& acc, const Unit& u, int wr, int wc, int fr, int fq) const {
        const int row0 = u.pm * BM + wr * 64 + fr, cc = wc * 32 + 8 * fq; const float* bp = bias + (size_t)u.e * 4096 + u.pn * BM + cc;
        f32x4 bv[2][2];
#pragma unroll
        for (int bj = 0; bj < 2; ++bj)
#pragma unroll
            for (int n = 0; n < 2; ++n) bv[bj][n] = *(const f32x4*)(bp + bj * HALF + 4 * n);
#pragma unroll
        for (int ai = 0; ai < 2; ++ai)
#pragma unroll
            for (int m = 0; m < 4; ++m) { unsigned char* rowp = (unsigned char*)act + (size_t)(row0 + ai * HALF + m * 16) * D + u.pn * HALF + cc;
                float o[8];
#pragma unroll
                for (int n = 0; n < 2; ++n) { const f32x4 g = acc[ai][0][m][n] * ws + bv[0][n], l = acc[ai][1][m][n] * ws + bv[1][n];
#pragma unroll
                    for (int k = 0; k < 4; ++k) { const float gl = fminf(g[k], 7.0f), li = fminf(fmaxf(l[k], -7.0f), 7.0f); o[n * 4 + k] = gl * sigmoidf_(1.702f * gl) * (li + 1.0f); } }
                v2u w; { unsigned t = 0u; t = __builtin_amdgcn_cvt_pk_fp8_f32(o[0], o[1], t, false); t = __builtin_amdgcn_cvt_pk_fp8_f32(o[2], o[3], t, true); w.x = t; t = 0u; t = __builtin_amdgcn_cvt_pk_fp8_f32(o[4], o[5], t, false); t = __builtin_amdgcn_cvt_pk_fp8_f32(o[6], o[7], t, true); w.y = t; }
                *(v2u*)rowp = w; }
    }
};
struct EpiDown {
    static constexpr bool PERM = true;
    bf16* ybuf; const float* bias; const int* list; const float* gates; float ws; const LAS int* tA; const LAS float* tG;
    __device__ __forceinline__ void operator()(const Acc& acc, const Unit& u, int wr, int wc, int fr, int fq) const {
        const int r0 = wr * 64 + fr, col0 = u.pn * BM + wc * 32 + 8 * fq; const float* bp = bias + (size_t)u.e * D + col0;
        f32x4 bv[2][2];
#pragma unroll
        for (int bj = 0; bj < 2; ++bj)
#pragma unroll
            for (int n = 0; n < 2; ++n) bv[bj][n] = *(const f32x4*)(bp + bj * HALF + 4 * n);
#pragma unroll
        for (int ai = 0; ai < 2; ++ai)
#pragma unroll
            for (int m = 0; m < 4; ++m) { const int r = r0 + ai * HALF + m * 16;
                int a; float g;
                if (tA) { a = tA[u.idx * 256 + r]; g = tG[u.idx * 256 + r]; } else if (r < u.rows) { a = list[u.e * MOE_CAP + u.mt * 256 + r]; g = gates[a]; } else { a = -1; g = 0.f; }
                if (a >= 0) { unsigned char* rowp = (unsigned char*)ybuf + (size_t)a * D + col0; const float g16 = g * 16.0f;
#pragma unroll
                    for (int bj = 0; bj < 2; ++bj) { const f32x4 v0 = (acc[ai][bj][m][0] * ws + bv[bj][0]) * g16, v1 = (acc[ai][bj][m][1] * ws + bv[bj][1]) * g16; v2u w;
                        { unsigned t = 0u; t = __builtin_amdgcn_cvt_pk_fp8_f32(v0[0], v0[1], t, false); t = __builtin_amdgcn_cvt_pk_fp8_f32(v0[2], v0[3], t, true); w.x = t; t = 0u; t = __builtin_amdgcn_cvt_pk_fp8_f32(v1[0], v1[1], t, false); t = __builtin_amdgcn_cvt_pk_fp8_f32(v1[2], v1[3], t, true); w.y = t; }
                        *(v2u*)(rowp + bj * HALF) = w; } } }
    }
};
}

#define XB_TMO      128
#define XB_XCNT(j)  (256  + 64 * (j))
#define XB_XSUB(j)  (1280 + 64 * (j))
#define XB_XGEN(j)  (2304 + 64 * (j))
#define XB_TOP      3328
#define XB_TOPGEN   3392
#define XCD_BAR_WORDS 3456
#define XB_SPIN_CAP (1u << 20)
__device__ __forceinline__ unsigned xb_ld(unsigned* p)              { return __hip_atomic_load(p, __ATOMIC_RELAXED, __HIP_MEMORY_SCOPE_AGENT); }
__device__ __forceinline__ unsigned xb_add(unsigned* p, unsigned v) { return __hip_atomic_fetch_add(p, v, __ATOMIC_RELAXED, __HIP_MEMORY_SCOPE_AGENT); }
__device__ __forceinline__ unsigned xb_xcc_id() { return (unsigned)__builtin_amdgcn_s_getreg((3 << 11) | 20) & 0xFu; }
#define XB_SPIN(cond, bar) do { unsigned _sp = 0; while (cond) { __builtin_amdgcn_s_sleep(1); \
    if ((++_sp & 255u) == 0u) { if (xb_ld(&(bar)[XB_TMO])) break; if (_sp > XB_SPIN_CAP) { atomicAdd(&(bar)[XB_TMO], 1u); break; } } } } while (0)
struct XcdBarrier { unsigned* bar; unsigned x; volatile LAS unsigned* st; };
__device__ __forceinline__ XcdBarrier xcd_barrier_post(unsigned* bar, volatile LAS unsigned* st) {
    XcdBarrier b; b.bar = bar; b.x = xb_xcc_id(); b.st = st;
    if (threadIdx.x == 0) (void)xb_add(&bar[XB_XCNT(b.x)], 1u);
    return b;
}
__device__ __forceinline__ void xcd_barrier_complete(unsigned* bar, unsigned x, unsigned& nloc, unsigned& nx) {
    const unsigned G = gridDim.x * gridDim.y * gridDim.z;
    unsigned sum, cnt, mine, sp = 0u;
    for (;;) {
        sum = 0u; cnt = 0u; mine = 0u;
#pragma unroll
        for (unsigned j = 0; j < 16; ++j) { const unsigned c = xb_ld(&bar[XB_XCNT(j)]); sum += c; cnt += (c > 0u) ? 1u : 0u; mine = (j == x) ? c : mine; }
        if (sum == G) break;
        __builtin_amdgcn_s_sleep(1);
        if ((++sp & 255u) == 0u) { if (xb_ld(&bar[XB_TMO])) break; if (sp > XB_SPIN_CAP) { atomicAdd(&bar[XB_TMO], 1u); break; } }
    }
    nloc = mine > 0u ? mine : 1u; nx = cnt > 0u ? cnt : 1u;
}
__device__ __forceinline__ void xcd_barrier(const XcdBarrier& b) {
    asm volatile("s_waitcnt vmcnt(0)" ::: "memory");
    __syncthreads();
    if (threadIdx.x == 0) {
        unsigned* bar = b.bar;
        __builtin_amdgcn_s_waitcnt(0);
        unsigned nloc = b.st[0], nx = b.st[1];
        if (nloc == 0u) { xcd_barrier_complete(bar, b.x, nloc, nx); b.st[0] = nloc; b.st[1] = nx; }
        const unsigned old = xb_add(&bar[XB_XSUB(b.x)], 1u);
        const unsigned gen = old / nloc;
        if (old + 1u == (gen + 1u) * nloc) {
            __builtin_amdgcn_fence(__ATOMIC_RELEASE, "agent");
            asm volatile("s_waitcnt vmcnt(0)" ::: "memory");
            const unsigned og = xb_add(&bar[XB_TOP], 1u);
            const unsigned tg = og / nx;
            if (og + 1u == (tg + 1u) * nx) xb_add(&bar[XB_TOPGEN], 1u);
            else XB_SPIN(xb_ld(&bar[XB_TOPGEN]) == tg, bar);
            __builtin_amdgcn_fence(__ATOMIC_ACQUIRE, "agent");
            xb_add(&bar[XB_XGEN(b.x)], 1u);
            asm volatile("s_waitcnt vmcnt(0)" ::: "memory");
        } else {
            XB_SPIN(xb_ld(&bar[XB_XGEN(b.x)]) == gen, bar);
            __builtin_amdgcn_fence(__ATOMIC_ACQUIRE, "agent");
            asm volatile("s_waitcnt vmcnt(0)" ::: "memory");
        }
    }
    __syncthreads();
}

__device__ __forceinline__ int tmap(int mode, int n) {
    if (mode == 0) return n;
    if (mode == 1) return n < GA1_COL ? n : (n < GA1_COL + 16 ? -1 : n - 16);
    const int j = n >> 1, par = n & 1; return 256 * (j >> 7) + 128 * par + (j & 127);
}
__device__ __forceinline__ void transpose_item(const float* W, int N, int Nout, int mode, bf16* WT, int item, int nnb, int lane) {
    const int nb = item % nnb, kbg = item / nnb, e = kbg >> 5, k0 = (kbg & 31) * 64, n0 = nb * 64;
    const int kq = lane & 7, nq = lane >> 3;
    const float* src = W + ((size_t)e * D + k0 + 8 * kq) * N + n0 + 4 * nq;
    f32x4 v[2][8]; bool inb[2];
#pragma unroll
    for (int g = 0; g < 2; ++g) { inb[g] = (n0 + 32 * g + 4 * nq) < N;
#pragma unroll
        for (int j = 0; j < 8; ++j) v[g][j] = inb[g] ? *(const f32x4*)(src + (size_t)j * N + 32 * g) : (f32x4){0.f, 0.f, 0.f, 0.f}; }
#pragma unroll
    for (int g = 0; g < 2; ++g)
#pragma unroll
        for (int c = 0; c < 4; ++c) { const int n = n0 + 32 * g + 4 * nq + c; const int dr = inb[g] ? tmap(mode, n) : -1;
            if (dr >= 0) { v4u w; w.x = pk2(v[g][0][c], v[g][1][c]); w.y = pk2(v[g][2][c], v[g][3][c]); w.z = pk2(v[g][4][c], v[g][5][c]); w.w = pk2(v[g][6][c], v[g][7][c]);
                *(v4u*)(WT + ((size_t)e * Nout + dr) * D + k0 + 8 * kq) = w; } }
}

__device__ __forceinline__ unsigned pk4_fp8(float a, float b, float c, float d) { unsigned w = 0u; w = __builtin_amdgcn_cvt_pk_fp8_f32(a, b, w, false); w = __builtin_amdgcn_cvt_pk_fp8_f32(c, d, w, true); return w; }
__device__ __forceinline__ void transpose_item_fp8(const float* W, int N, int Nout, int mode, unsigned char* WT, int item, int nnb, int lane, float scale, const float* rowscale = nullptr) {
    const int nb = item % nnb, kbg = item / nnb, e = kbg >> 4, k0 = (kbg & 15) * 128, n0 = nb * 32;
    const int kq = lane & 7, nq = lane >> 3;
    const int nv = n0 + 4 * nq; int ns = nv; if (mode == 3) { const int np = TILES_FP8[nv >> 8] * 256 + (nv & 255); ns = np < GA1_COL ? np : np + 16; }
    const float* src = W + ((size_t)e * D + k0 + 16 * kq) * N + ns;
    f32x4 v[16];
#pragma unroll
    for (int j = 0; j < 16; ++j) v[j] = __builtin_nontemporal_load((const f32x4*)(src + (size_t)j * N)) * (rowscale ? scale * rowscale[k0 + 16 * kq + j] : scale);
#pragma unroll
    for (int c = 0; c < 4; ++c) { const int dr = mode == 3 ? nv + c : tmap(mode, nv + c);
        v4u w; w.x = pk4_fp8(v[0][c], v[1][c], v[2][c], v[3][c]); w.y = pk4_fp8(v[4][c], v[5][c], v[6][c], v[7][c]); w.z = pk4_fp8(v[8][c], v[9][c], v[10][c], v[11][c]); w.w = pk4_fp8(v[12][c], v[13][c], v[14][c], v[15][c]);
        __builtin_nontemporal_store(w, (v4u*)(WT + ((size_t)e * Nout + dr) * D + k0 + 16 * kq)); }
}

__device__ __forceinline__ void ln1_finish(const float* stats, float* fst, int row) {
    const f32x4* p = (const f32x4*)(stats + (size_t)row * 64); float s1 = 0.f, s2 = 0.f;
#pragma unroll
    for (int i = 0; i < 16; ++i) { const f32x4 v = p[i]; s1 += v[0] + v[2]; s2 += v[1] + v[3]; }
    const float mu = s1 * (1.0f / D), rstd = __builtin_amdgcn_rsqf(s2 * (1.0f / D) - mu * mu + EPS);
    *(f32x2*)(fst + 2 * (size_t)row) = (f32x2){mu, rstd};
}
__device__ __forceinline__ void ln_apply(f32x4 (&v)[8], const float* g, const float* b, int lane) {
    float s = 0.f;
#pragma unroll
    for (int j = 0; j < 8; ++j) s += (v[j][0] + v[j][1]) + (v[j][2] + v[j][3]);
    const float mean = wave_sum(s) * (1.0f / D); float s2 = 0.f;
#pragma unroll
    for (int j = 0; j < 8; ++j) { v[j] = v[j] - mean; s2 += (v[j][0] * v[j][0] + v[j][1] * v[j][1]) + (v[j][2] * v[j][2] + v[j][3] * v[j][3]); }
    const float rstd = __builtin_amdgcn_rsqf(wave_sum(s2) * (1.0f / D) + EPS);
#pragma unroll
    for (int j = 0; j < 8; ++j) { const f32x4 gg = *(const f32x4*)(g + 4 * lane + 256 * j), bb = *(const f32x4*)(b + 4 * lane + 256 * j); v[j] = v[j] * rstd * gg + bb; }
}
#define COLB(j) (8 * lane + 512 * ((j) >> 1) + 4 * ((j) & 1))
__device__ __forceinline__ void ln_apply_b(f32x4 (&v)[8], const float* g, const float* b, int lane) {
    float s = 0.f;
#pragma unroll
    for (int j = 0; j < 8; ++j) s += (v[j][0] + v[j][1]) + (v[j][2] + v[j][3]);
    const float mean = wave_sum(s) * (1.0f / D); float s2 = 0.f;
#pragma unroll
    for (int j = 0; j < 8; ++j) { v[j] = v[j] - mean; s2 += (v[j][0] * v[j][0] + v[j][1] * v[j][1]) + (v[j][2] * v[j][2] + v[j][3] * v[j][3]); }
    const float rstd = __builtin_amdgcn_rsqf(wave_sum(s2) * (1.0f / D) + EPS);
#pragma unroll
    for (int j = 0; j < 8; ++j) { const f32x4 gg = *(const f32x4*)(g + COLB(j)), bb = *(const f32x4*)(b + COLB(j)); v[j] = v[j] * rstd * gg + bb; }
}
__device__ __forceinline__ void ln_apply_b_st(f32x4 (&v)[8], const float* g, const float* b, int lane, float& mean_o, float& rstd_o) {
    float s = 0.f;
#pragma unroll
    for (int j = 0; j < 8; ++j) s += (v[j][0] + v[j][1]) + (v[j][2] + v[j][3]);
    const float mean = wave_sum(s) * (1.0f / D); float s2 = 0.f;
#pragma unroll
    for (int j = 0; j < 8; ++j) { v[j] = v[j] - mean; s2 += (v[j][0] * v[j][0] + v[j][1] * v[j][1]) + (v[j][2] * v[j][2] + v[j][3] * v[j][3]); }
    const float rstd = __builtin_amdgcn_rsqf(wave_sum(s2) * (1.0f / D) + EPS);
#pragma unroll
    for (int j = 0; j < 8; ++j) { const f32x4 gg = *(const f32x4*)(g + COLB(j)), bb = *(const f32x4*)(b + COLB(j)); v[j] = v[j] * rstd * gg + bb; }
    mean_o = mean; rstd_o = rstd;
}
__device__ __forceinline__ void bf16x8_to_f32(const v4u w, f32x4& a, f32x4& b) {
    a = (f32x4){__uint_as_float(w.x << 16), __uint_as_float(w.x & 0xffff0000u), __uint_as_float(w.y << 16), __uint_as_float(w.y & 0xffff0000u)};
    b = (f32x4){__uint_as_float(w.z << 16), __uint_as_float(w.z & 0xffff0000u), __uint_as_float(w.w << 16), __uint_as_float(w.w & 0xffff0000u)}; }
__device__ __forceinline__ void row_load_bf16_b(const bf16* p, f32x4 (&v)[8], int lane) {
#pragma unroll
    for (int j2 = 0; j2 < 4; ++j2) bf16x8_to_f32(*(const v4u*)(p + 8 * lane + 512 * j2), v[2 * j2], v[2 * j2 + 1]);
}
__device__ __forceinline__ void row_store_bf16_b(bf16* o, const f32x4 (&v)[8], int lane) {
#pragma unroll
    for (int j2 = 0; j2 < 4; ++j2) { v4u w; w.x = pk2(v[2 * j2][0], v[2 * j2][1]); w.y = pk2(v[2 * j2][2], v[2 * j2][3]); w.z = pk2(v[2 * j2 + 1][0], v[2 * j2 + 1][1]); w.w = pk2(v[2 * j2 + 1][2], v[2 * j2 + 1][3]); *(v4u*)(o + 8 * lane + 512 * j2) = w; }
}
__device__ __forceinline__ void row_store_f32_b(float* o, const f32x4 (&v)[8], int lane) {
#pragma unroll
    for (int j = 0; j < 8; ++j) *(f32x4*)(o + COLB(j)) = v[j];
}
__device__ __forceinline__ void row_store_f32(float* o, const f32x4 (&v)[8], int lane) {
#pragma unroll
    for (int j = 0; j < 8; ++j) *(f32x4*)(o + 4 * lane + 256 * j) = v[j];
}
__device__ __forceinline__ void row_store_bf16(bf16* o, const f32x4 (&v)[8], int lane) {
#pragma unroll
    for (int j = 0; j < 8; ++j) { v2u w; w.x = pk2(v[j][0], v[j][1]); w.y = pk2(v[j][2], v[j][3]); *(v2u*)(o + 4 * lane + 256 * j) = w; }
}
__device__ __forceinline__ f32x4 ld_bf16x4(const bf16* p) { const v2u w = *(const v2u*)p; return (f32x4){bf2f(w.x & 0xffffu), bf2f(w.x >> 16), bf2f(w.y & 0xffffu), bf2f(w.y >> 16)}; }


typedef float f32x16 __attribute__((ext_vector_type(16)));
typedef short s16x4_t __attribute__((ext_vector_type(4)));
typedef __bf16 bf16x2_t __attribute__((ext_vector_type(2)));
__device__ __forceinline__ unsigned cvtpk(float lo, float hi) { f32x2 v = {lo, hi}; bf16x2_t b = __builtin_convertvector(v, bf16x2_t); return __builtin_bit_cast(unsigned, b); }
__device__ __forceinline__ int crow(int reg, int hh) { return (reg & 3) + 8 * (reg >> 2) + 4 * hh; }
__device__ __forceinline__ v4u piece16(const float (&v)[16], int hh2) {
    v4u w; if (hh2 == 0) { w.x = cvtpk(v[0], v[1]); w.y = cvtpk(v[2], v[3]); w.z = cvtpk(v[8], v[9]); w.w = cvtpk(v[10], v[11]); }
    else { w.x = cvtpk(v[4], v[5]); w.y = cvtpk(v[6], v[7]); w.z = cvtpk(v[12], v[13]); w.w = cvtpk(v[14], v[15]); }
    return w; }
constexpr int PP_GS = 0, PP_KS = 33792, PP_QI = 67584, PP_KH = 83968, PP_KI = 100352, PP_SEG = 116736, PP_GT = PP_SEG + 2048;

struct PrepIn { unsigned short kin[16]; v4u q0, q1; };
template <int KIND>
__device__ __forceinline__ void prep_load(PrepIn& R, int tid, int wave, const bf16* proj_, int b, int h, int c, int sl) {
    constexpr int DK = KIND == 0 ? 256 : 128; constexpr int QCOL = KIND == 0 ? GQ : HQ, KCOL = KIND == 0 ? GK : HF;
    const size_t tok0 = (size_t)b * SEQ + (size_t)c * 64; const int d = tid & 127, seg = wave >> 1, d0 = 128 * sl;
#pragma unroll
    for (int t = 0; t < 16; ++t) R.kin[t] = proj_[(tok0 + seg * 16 + t) * NPROJ + KCOL + h * DK + d0 + d];
    const bf16* qp = proj_ + (tok0 + (tid >> 3)) * NPROJ + QCOL + h * DK + d0 + 16 * (tid & 7);
    R.q0 = *(const v4u*)qp; R.q1 = *(const v4u*)(qp + 8);
}
template <int KIND>
__device__ __forceinline__ void prep_unit(LAS unsigned char* lds, int tid, int b, int h, int c, int nb_, int nh_, int nc_, bool has_next, PrepIn& cur, const bf16* proj_, const float* ga1_, const float* w_a2_, const float* b_a_, const float* lbt_,
                                          unsigned char* QF, unsigned char* KF, unsigned char* PF, float* LAM, unsigned char* VF) {
    constexpr int DK = KIND == 0 ? 256 : 128, DV = KIND == 0 ? 512 : 128, NSLAB = DK / 128, NEB = DV / 128;
    constexpr int QCOL = KIND == 0 ? GQ : HQ, KCOL = KIND == 0 ? GK : HF, VCOL = KIND == 0 ? GV : HI;
    const int lane = tid & 63, wave = __builtin_amdgcn_readfirstlane(tid >> 6), r = lane & 31, hh = lane >> 5;
    const size_t tok0 = (size_t)b * SEQ + (size_t)c * 64;
    LAS float* Gs = (LAS float*)(lds + PP_GS); LAS float* Ks = (LAS float*)(lds + PP_KS); LAS float* SEGT = (LAS float*)(lds + PP_SEG); LAS float* GT = (LAS float*)(lds + PP_GT);
    LAS unsigned char* QI = lds + PP_QI; LAS unsigned char* KH = lds + PP_KH; LAS unsigned char* KI = lds + PP_KI;
    f32x16 pacc;
#pragma unroll
    for (int i = 0; i < 16; ++i) pacc[i] = 0.f;
#pragma unroll
    for (int sl = 0; sl < NSLAB; ++sl) {
        const int d0 = 128 * sl;
        PrepIn nxt = cur;
        if (sl + 1 < NSLAB) prep_load<KIND>(nxt, tid, wave, proj_, b, h, c, sl + 1);
        else if (has_next) prep_load<KIND>(nxt, tid, wave, proj_, nb_, nh_, nc_, 0);
        const v4u q0 = cur.q0, q1 = cur.q1;
        {
            const int d = tid & 127, seg = wave >> 1;
            float w2[16]; float bb = 0.f, lb = 0.f;
            if constexpr (KIND == 0) {
#pragma unroll
                for (int q = 0; q < 16; ++q) w2[q] = w_a2_[q * 1024 + h * 256 + d0 + d];
                bb = b_a_[h * 256 + d0 + d];
            } else { lb = lbt_[h * 128 + d]; }
            float run = 0.f;
#pragma unroll
            for (int t = 0; t < 16; ++t) { const int i = seg * 16 + t; const size_t row = tok0 + i; float g, kv;
                if constexpr (KIND == 0) { float z = bb; const float* ga = ga1_ + row * 16;
#pragma unroll
                    for (int q = 0; q < 16; ++q) z += ga[q] * w2[q];
                    g = (fminf(z, 0.f) - __logf(1.0f + __expf(-fabsf(z)))) * 0.0625f; kv = bf2f(cur.kin[t]); }
                else { const float hf = bf2f(cur.kin[t]); const float f = lb + (1.0f - lb) * sigmoidf_(hf); g = __logf(f); kv = 1.0f - f; }
                run += g; Gs[i * 132 + d] = run; Ks[i * 132 + d] = kv; }
            SEGT[seg * 128 + d] = run;
        }
        __syncthreads();
        {   const int d = tid & 127, seg = wave >> 1; const float t0 = SEGT[d], t1 = SEGT[128 + d], t2 = SEGT[256 + d], t3 = SEGT[384 + d];
            const float off = seg == 0 ? 0.f : (seg == 1 ? t0 : (seg == 2 ? t0 + t1 : (t0 + t1) + t2));
            if (seg > 0) {
#pragma unroll
                for (int t = 0; t < 16; ++t) Gs[(seg * 16 + t) * 132 + d] += off; }
            if (seg == 3) { const float gt = off + t3; GT[d] = gt; LAM[d0 + d] = __expf(gt); }
        }
        __syncthreads();
        {
            const int ks = tid & 7, i = tid >> 3;
            float qv[16];
            qv[0] = bf2f(q0.x & 0xffffu); qv[1] = bf2f(q0.x >> 16); qv[2] = bf2f(q0.y & 0xffffu); qv[3] = bf2f(q0.y >> 16); qv[4] = bf2f(q0.z & 0xffffu); qv[5] = bf2f(q0.z >> 16); qv[6] = bf2f(q0.w & 0xffffu); qv[7] = bf2f(q0.w >> 16);
            qv[8] = bf2f(q1.x & 0xffffu); qv[9] = bf2f(q1.x >> 16); qv[10] = bf2f(q1.y & 0xffffu); qv[11] = bf2f(q1.y >> 16); qv[12] = bf2f(q1.z & 0xffffu); qv[13] = bf2f(q1.z >> 16); qv[14] = bf2f(q1.w & 0xffffu); qv[15] = bf2f(q1.w >> 16);
            float qt[16], kh[16], qp_[16];
#pragma unroll
            for (int q4 = 0; q4 < 4; ++q4) { const f32x4 g4 = *(const LAS f32x4*)(Gs + i * 132 + 16 * ks + 4 * q4), k4 = *(const LAS f32x4*)(Ks + i * 132 + 16 * ks + 4 * q4), t4 = *(const LAS f32x4*)(GT + 16 * ks + 4 * q4);
#pragma unroll
                for (int p = 0; p < 4; ++p) { const int dd = 4 * q4 + p; const float qq = KIND == 0 ? qv[dd] * 0.0625f : qv[dd] * sigmoidf_(qv[dd]);
                    qt[dd] = qq * __expf(g4[p]); qp_[dd] = qq * __expf(g4[p] - t4[p]); kh[dd] = k4[p] * __expf(-g4[p]); } }
#pragma unroll
            for (int h2 = 0; h2 < 2; ++h2) { const int slot = ((2 * ks + h2) ^ i) & 15;
                *(LAS v4u*)(QI + i * 256 + slot * 16) = piece16(qt, h2); *(LAS v4u*)(KH + i * 256 + slot * 16) = piece16(kh, h2);
                *(v4u*)(QF + (size_t)i * (DK * 2) + sl * 256 + slot * 16) = piece16(qp_, h2); }
        }
        __syncthreads();
        if (wave < 3) {
            const int jt = wave == 2 ? 1 : 0, it = wave == 0 ? 0 : 1, j = 32 * jt + r, i = 32 * it + r;
#pragma unroll
            for (int ks = 0; ks < 8; ++ks) { const bf16x8 a = *(const LAS bf16x8*)(KH + j * 256 + (((2 * ks + hh) ^ j) & 15) * 16), bq = *(const LAS bf16x8*)(QI + i * 256 + (((2 * ks + hh) ^ i) & 15) * 16);
                pacc = __builtin_amdgcn_mfma_f32_32x32x16_bf16(a, bq, pacc, 0, 0, 0); }
        }
        {
            const int d = tid & 127, s4 = tid >> 7; const float gt = GT[d]; float kt[16];
#pragma unroll
            for (int t = 0; t < 16; ++t) { const int j = 16 * s4 + t; kt[t] = Ks[j * 132 + d] * __expf(gt - Gs[j * 132 + d]); }
#pragma unroll
            for (int h2 = 0; h2 < 2; ++h2) *(LAS v4u*)(KI + d * 128 + (((2 * s4 + h2) ^ (d >> 1)) & 7) * 16) = piece16(kt, h2);
        }
        __syncthreads();
#pragma unroll
        for (int q = 0; q < 2; ++q) { const int pc = tid + 512 * q; *(v4u*)(KF + (size_t)d0 * 128 + pc * 16) = *(const LAS v4u*)(KI + pc * 16); }
        __syncthreads();
        cur = nxt;
    }
    if (wave < 3) {
        if (wave != 1) {
#pragma unroll
            for (int q = 0; q < 16; ++q) if (crow(q, hh) > r) pacc[q] = 0.f; }
#pragma unroll
        for (int s2 = 0; s2 < 2; ++s2) { v4u w; w.x = cvtpk(pacc[8 * s2 + 0], pacc[8 * s2 + 1]); w.y = cvtpk(pacc[8 * s2 + 2], pacc[8 * s2 + 3]); w.z = cvtpk(pacc[8 * s2 + 4], pacc[8 * s2 + 5]); w.w = cvtpk(pacc[8 * s2 + 6], pacc[8 * s2 + 7]);
            *(v4u*)(PF + (2 * wave + s2) * 1024 + lane * 16) = w; }
    }
}

__device__ __forceinline__ const bf16* vblock_src(int u, const bf16* proj_) {
    if (u < 4096) { const int pc = u >> 2, eb = u & 3, pair = pc >> 7, c = pc & 127; return proj_ + ((size_t)(pair >> 2) * SEQ + (size_t)c * 64) * NPROJ + GV + (pair & 3) * 512 + eb * 128; }
    const int pc = u - 4096, pair = pc >> 7, c = pc & 127; return proj_ + ((size_t)(pair >> 4) * SEQ + (size_t)c * 64) * NPROJ + HI + (pair & 15) * 128;
}
__device__ __forceinline__ void vblock_load(v2u (&vin)[4], const bf16* src, int tid) {
#pragma unroll
    for (int q = 0; q < 4; ++q) vin[q] = *(const v2u*)(src + (size_t)((tid >> 5) + 16 * q) * NPROJ + (tid & 31) * 4);
}
__device__ __forceinline__ void vblock_run(LAS unsigned char* lds, int tid, const v2u (&vin)[4], unsigned char* dst) {
    LAS float* Ks = (LAS float*)(lds + PP_KS); LAS unsigned char* KI = lds + PP_KI;
#pragma unroll
    for (int q = 0; q < 4; ++q) { const int j = (tid >> 5) + 16 * q, e4 = (tid & 31) * 4; const v2u w = vin[q]; *(LAS f32x4*)(Ks + j * 132 + e4) = (f32x4){bf2f(w.x & 0xffffu), bf2f(w.x >> 16), bf2f(w.y & 0xffffu), bf2f(w.y >> 16)}; }
    __syncthreads();
    {   const int e = tid & 127, s4 = tid >> 7; float vv[16];
#pragma unroll
        for (int t = 0; t < 16; ++t) vv[t] = Ks[(16 * s4 + t) * 132 + e];
#pragma unroll
        for (int h2 = 0; h2 < 2; ++h2) *(LAS v4u*)(KI + e * 128 + (((2 * s4 + h2) ^ (e >> 1)) & 7) * 16) = piece16(vv, h2);
    }
    __syncthreads();
#pragma unroll
    for (int q = 0; q < 2; ++q) { const int pc = tid + 512 * q; *(v4u*)(dst + pc * 16) = *(const LAS v4u*)(KI + pc * 16); }
    __syncthreads();
}

__device__ __forceinline__ void lds_wait_ge(volatile LAS unsigned* p, unsigned want) { unsigned n = 0; while (*p < want) { __builtin_amdgcn_s_sleep(1); if (++n > (1u << 22)) break; } }
template <int KIND>
__device__ __forceinline__ void scan_item(LAS unsigned char* lds, volatile LAS unsigned* flg, int role, int lane, unsigned seq0, int pflags, const unsigned char* QF, const unsigned char* KF, const unsigned char* PF, const unsigned char* LAM, const unsigned char* VF, bf16* out) {
    constexpr int DK = KIND == 0 ? 256 : 128, DV = KIND == 0 ? 512 : 128, NDT = DK / 32, QB = 64 * DK * 2, KB = DK * 128, VB = DV * 128, NC = KIND == 0 ? 2 : 4;
    constexpr int SQ = 0, SK = QB, SP = QB + KB, SL = SP + 6144, SV = SL + 1024, STG = SV + NC * 4096;
    static_assert(2 * STG <= MISC_OFF, "scan stages fit under the LDS control words");
#define DMA1(gu, l) __builtin_amdgcn_global_load_lds((const unsigned*)((const unsigned char*)(gu) + (size_t)loff), (LAS unsigned*)(l), 16, 0, 0)
    if ((pflags & 32) && role >= NC) return;
    if (role == NC || role == NC + 2) {
        unsigned loff = (unsigned)lane * 16u; asm volatile("" : "+v"(loff));
        unsigned lvoff = (unsigned)(lane >> 2) * (unsigned)(NPROJ * 2) + (unsigned)(lane & 3) * 16u; asm volatile("" : "+v"(lvoff));
#pragma nounroll
        for (int c = 0; c < 128; ++c) { const unsigned seq = seq0 + c; const int st = seq & 1; LAS unsigned char* sb_ = lds + st * STG;
            if (st != ((role - NC) >> 1)) continue;
#pragma unroll
            for (int k = 0; k < NC; ++k) lds_wait_ge(flg + 4 + 4 * st + k, seq >> 1);
            asm volatile("" ::: "memory");
            const unsigned char* g_;
#pragma unroll
            for (int k = 0; k < NC; ++k)
#pragma unroll
                for (int q_ = 0; q_ < 4; ++q_) __builtin_amdgcn_global_load_lds((const unsigned*)(VF + ((size_t)c * 64 + 16 * q_) * (NPROJ * 2) + k * 64 + (size_t)lvoff), (LAS unsigned*)(sb_ + SV + k * 4096 + q_ * 1024), 16, 0, 0);
            g_ = PF + (size_t)c * 6144;
#pragma unroll
            for (int q_ = 0; q_ < 6; ++q_) DMA1(g_ + q_ * 1024, sb_ + SP + q_ * 1024);
            DMA1(LAM + (size_t)c * 1024, sb_ + SL);
            g_ = QF + (size_t)c * QB;
#pragma unroll
            for (int q_ = 0; q_ < QB / 1024; ++q_) DMA1(g_ + q_ * 1024, sb_ + SQ + q_ * 1024);
            VM_WAIT(); flg[st] = seq + 1u; }
        return;
    }
    if (role == NC + 1 || role == NC + 3) {
        unsigned loff = (unsigned)lane * 16u; asm volatile("" : "+v"(loff));
#pragma nounroll
        for (int c = 0; c < 128; ++c) { const unsigned seq = seq0 + c; const int st = seq & 1; LAS unsigned char* sb_ = lds + st * STG;
            if (st != ((role - NC) >> 1)) continue;
#pragma unroll
            for (int k = 0; k < NC; ++k) lds_wait_ge(flg + 12 + 4 * st + k, seq >> 1);
            asm volatile("" ::: "memory");
            const unsigned char* g_ = KF + (size_t)c * KB;
#pragma unroll
            for (int q_ = 0; q_ < KB / 1024; ++q_) DMA1(g_ + q_ * 1024, sb_ + SK + q_ * 1024);
            VM_WAIT(); flg[2 + st] = seq + 1u; }
        return;
    }
#undef DMA1
    if (role > NC + 3) return;
    const int r = lane & 31, hh = lane >> 5;
    bf16* outw = out + role * 32;
    f32x16 S[NDT];
#pragma unroll
    for (int dt = 0; dt < NDT; ++dt)
#pragma unroll
        for (int q = 0; q < 16; ++q) S[dt][q] = 0.f;
#pragma nounroll
    for (int c = 0; c < 128; ++c) {
        const unsigned seq = seq0 + c; const int st = seq & 1;
        LAS unsigned char* base = lds + st * STG;
        if (!(pflags & 32)) lds_wait_ge(flg + st, seq + 1u);
        asm volatile("" ::: "memory");
        if (pflags & 16) { flg[4 + 4 * st + role] = (seq >> 1) + 1u; lds_wait_ge(flg + 2 + st, seq + 1u); flg[12 + 4 * st + role] = (seq >> 1) + 1u; continue; }
#define DSR(dst, addr) asm volatile("ds_read_b128 %0, %1" : "=v"(dst) : "v"(addr) : "memory")
#define LGK(n) do { asm volatile("s_waitcnt lgkmcnt(" #n ")" ::: "memory"); __builtin_amdgcn_sched_barrier(0); } while (0)
        constexpr int NKS = DK / 16;
        unsigned sbase = (unsigned)(size_t)base; asm volatile("" : "+v"(sbase));
        const unsigned aV = sbase + SV + role * 4096 + (4 * hh + ((lane & 15) >> 2)) * 64 + (16 * ((lane >> 4) & 1) + 4 * (lane & 3)) * 2, aP = sbase + SP + lane * 16;
        const unsigned aQ0 = (sbase + SQ + r * (DK * 2)) | ((((r >> 1) & 7) << 5) | (((r & 1) ^ hh) << 4));
        const unsigned aK = sbase + SK + r * 128, aL = sbase + SL + hh * 16;
        const unsigned swz = ((r >> 1) & 7) << 4;
        s16x4_t vt[4][2];
#define VFR(s_) __builtin_shufflevector(vt[s_][0], vt[s_][1], 0, 1, 2, 3, 4, 5, 6, 7)
        {
            f32x4 lm[2][4];
#pragma unroll
            for (int s_ = 0; s_ < 4; ++s_) DSR(lm[0][s_], aL + (unsigned)((8 * s_) * 4));
#pragma unroll
            for (int dt = 0; dt < NDT; ++dt) {
                __builtin_amdgcn_sched_barrier(0);
                if (dt + 1 < NDT) {
#pragma unroll
                    for (int s_ = 0; s_ < 4; ++s_) DSR(lm[(dt + 1) & 1][s_], aL + (unsigned)((32 * (dt + 1) + 8 * s_) * 4));
                    LGK(4); } else { LGK(0); }
#pragma unroll
                for (int g = 0; g < 4; ++g)
#pragma unroll
                    for (int p = 0; p < 4; ++p) S[dt][4 * g + p] *= lm[dt & 1][g][p];
                __builtin_amdgcn_sched_barrier(0);
            }
        }
        f32x16 O[2];
#pragma unroll
        for (int it = 0; it < 2; ++it)
#pragma unroll
            for (int q = 0; q < 16; ++q) O[it][q] = 0.f;
        bf16x8 qf[2][2], pf[6];
#define SCAN_LOADQ(buf, ks) do { const unsigned a_ = (aQ0 ^ (unsigned)((((ks) & 7) << 5))) + (unsigned)((((ks) >> 3) << 8)); DSR(qf[buf][0], a_); DSR(qf[buf][1], a_ + 32u * (DK * 2)); } while (0)
        SCAN_LOADQ(0, 0);
#pragma unroll
        for (int ks = 0; ks < NKS; ++ks) {
            __builtin_amdgcn_sched_barrier(0);
            if (ks + 1 < NKS) { SCAN_LOADQ((ks + 1) & 1, ks + 1); LGK(2); }
            else {
#pragma unroll
                for (int f = 0; f < 4; ++f) DSR(pf[f], aP + f * 1024);
#pragma unroll
                for (int s_ = 0; s_ < 4; ++s_) {
                    asm volatile("ds_read_b64_tr_b16 %0, %1" : "=v"(vt[s_][0]) : "v"(aV + (unsigned)((16 * s_) * 64)) : "memory");
                    asm volatile("ds_read_b64_tr_b16 %0, %1" : "=v"(vt[s_][1]) : "v"(aV + (unsigned)((16 * s_ + 8) * 64)) : "memory"); }
                LGK(12); }
            const int dt = ks >> 1, s2 = ks & 1;
            v4u sw; sw.x = cvtpk(S[dt][8 * s2 + 0], S[dt][8 * s2 + 1]); sw.y = cvtpk(S[dt][8 * s2 + 2], S[dt][8 * s2 + 3]); sw.z = cvtpk(S[dt][8 * s2 + 4], S[dt][8 * s2 + 5]); sw.w = cvtpk(S[dt][8 * s2 + 6], S[dt][8 * s2 + 7]);
            const bf16x8 sb = __builtin_bit_cast(bf16x8, sw);
            O[0] = __builtin_amdgcn_mfma_f32_32x32x16_bf16(sb, qf[ks & 1][0], O[0], 0, 0, 0);
            O[1] = __builtin_amdgcn_mfma_f32_32x32x16_bf16(sb, qf[ks & 1][1], O[1], 0, 0, 0);
            __builtin_amdgcn_sched_barrier(0);
        }
#undef SCAN_LOADQ
        __builtin_amdgcn_sched_barrier(0);
        DSR(pf[4], aP + 4 * 1024); DSR(pf[5], aP + 5 * 1024);
        LGK(2);

#pragma unroll
        for (int s = 0; s < 2; ++s) O[0] = __builtin_amdgcn_mfma_f32_32x32x16_bf16(VFR(s), pf[s], O[0], 0, 0, 0);
#pragma unroll
        for (int s = 0; s < 2; ++s) O[1] = __builtin_amdgcn_mfma_f32_32x32x16_bf16(VFR(s), pf[2 + s], O[1], 0, 0, 0);
        __builtin_amdgcn_sched_barrier(0);
        LGK(0);
#pragma unroll
        for (int s = 2; s < 4; ++s) O[1] = __builtin_amdgcn_mfma_f32_32x32x16_bf16(VFR(s), pf[2 + s], O[1], 0, 0, 0);
        __builtin_amdgcn_sched_barrier(0);
        flg[4 + 4 * st + role] = (seq >> 1) + 1u;
        if (!(pflags & 8)) {   const bf16* opu = outw + (size_t)c * 64 * D;
            unsigned lo = (unsigned)(r * D + 4 * hh) * 2u; asm volatile("" : "+v"(lo));
#pragma unroll
            for (int it = 0; it < 2; ++it)
#pragma unroll
                for (int g = 0; g < 4; ++g) { v2u w; w.x = cvtpk(O[it][4 * g + 0], O[it][4 * g + 1]); w.y = cvtpk(O[it][4 * g + 2], O[it][4 * g + 3]);
                    *(v2u*)((unsigned char*)(opu + (size_t)(32 * it) * D + 8 * g) + (size_t)lo) = w; } }
        if (!(pflags & 32)) lds_wait_ge(flg + 2 + st, seq + 1u);
        asm volatile("" ::: "memory");
        __builtin_amdgcn_sched_barrier(0);
        {
            constexpr int NF = 4 * NDT;
            bf16x8 ring[8];
#define SCAN_KADDR(j) (aK + (unsigned)(((j) % NDT) * 4096) + (unsigned)((((2 * ((j) / NDT) + hh) << 4) ^ swz) & 0x70))
#pragma unroll
            for (int j = 0; j < 8; ++j) DSR(ring[j], SCAN_KADDR(j));
#pragma unroll
            for (int j = 0; j < NF; ++j) {
                __builtin_amdgcn_sched_barrier(0);
                const int young = (NF - 1 - j) < 7 ? (NF - 1 - j) : 7;
                if (young == 7) LGK(7); else if (young == 6) LGK(6); else if (young == 5) LGK(5); else if (young == 4) LGK(4); else if (young == 3) LGK(3); else if (young == 2) LGK(2); else if (young == 1) LGK(1); else LGK(0);
                S[j % NDT] = __builtin_amdgcn_mfma_f32_32x32x16_bf16(ring[j & 7], VFR(j / NDT), S[j % NDT], 0, 0, 0);
                __builtin_amdgcn_sched_barrier(0);
                if (j + 8 < NF) DSR(ring[j & 7], SCAN_KADDR(j + 8));
            }
#undef SCAN_KADDR
        }
#undef DSR
#undef LGK
#undef VFR
        LDS_WAIT();
        flg[12 + 4 * st + role] = (seq >> 1) + 1u;
    }
}

struct Args { const float* in[25]; float* out; unsigned char* ws; int ph_lo, ph_hi, flags, pad; };
constexpr int N_PHASES = 17;

__global__ void __launch_bounds__(NTHREADS, 2) fwd_kernel(Args args) {
    extern __shared__ __attribute__((aligned(16))) unsigned char lds_raw[];
    LAS unsigned char* lds = (LAS unsigned char*)lds_raw;
    volatile LAS unsigned* MISC = (volatile LAS unsigned*)(lds + MISC_OFF);
    const int tid = threadIdx.x, lane = tid & 63, wave = __builtin_amdgcn_readfirstlane(tid >> 6);
    const int G = gridDim.x, bx = blockIdx.x;
    const int vcu = (G % 8 == 0) ? (bx % 8) * (G / 8) + bx / 8 : bx;
    const int gw = vcu * NWAVES + wave, NGW = G * NWAVES;
    unsigned* ctl = (unsigned*)(args.ws + WS_CTL);
#define x_in (args.in[0])
#define mem_in (args.in[1])
#define w_in (args.in[2])
#define b_in (args.in[3])
#define w_a2 (args.in[4])
#define b_a (args.in[5])
#define gla_g (args.in[6])
#define hgrn_g (args.in[7])
#define lb_logits (args.in[8])
#define w_mix_o (args.in[9])
#define w_xq (args.in[10])
#define w_mem_kv (args.in[11])
#define w_xo (args.in[12])
#define w_router (args.in[13])
#define b_router (args.in[14])
#define w_gate_up (args.in[15])
#define b_gate_up (args.in[16])
#define w_down (args.in[17])
#define b_down (args.in[18])
#define ln1_g (args.in[19])
#define ln1_b (args.in[20])
#define ln2_g (args.in[21])
#define ln2_b (args.in[22])
#define ln3_g (args.in[23])
#define ln3_b (args.in[24])
#define WSP(type, off) ((type*)(args.ws + (off)))
#define ws_ (args.ws)
#define Win_t WSP(bf16, WS_WIN_T)
#define Wo_t WSP(bf16, WS_WO_T)
#define Wxq_t WSP(bf16, WS_WXQ_T)
#define Wkv_t WSP(bf16, WS_WKV_T)
#define Wxo_t WSP(bf16, WS_WXO_T)
#define Wgu_t WSP(bf16, WS_WGU_T)
#define Wd_t WSP(bf16, WS_WD_T)
#define xb WSP(bf16, WS_XB)
#define memb WSP(bf16, WS_MEMB)
#define ga1 WSP(float, WS_GA1)
#define binc WSP(float, WS_BINC)
#define bgup WSP(float, WS_BGUP)
#define lbt WSP(float, WS_LB)
#define proj WSP(bf16, WS_PROJ)
#define glog WSP(float, WS_GLOG)
#define ogla WSP(float, WS_OGLA)
#define oh WSP(float, WS_OH)
#define merged WSP(bf16, WS_MERGED)
#define pre1 WSP(float, WS_PRE1)
#define h1 WSP(float, WS_H1)
#define h1b WSP(bf16, WS_H1B)
#define qb WSP(bf16, WS_Q)
#define kk WSP(bf16, WS_KK)
#define vt WSP(bf16, WS_VT)
#define sc WSP(float, WS_SC)
#define Pb WSP(bf16, WS_P)
#define ao WSP(bf16, WS_AO)
#define pre2 WSP(float, WS_PRE2)
#define h2 WSP(float, WS_H2)
#define h2b WSP(bf16, WS_H2B)
#define list WSP(int, WS_LIST)
#define gates WSP(float, WS_GATES)
#define act WSP(bf16, WS_ACT)
#define ybuf WSP(bf16, WS_YBUF)
#define ecnt (ctl + CW_CNT)

    for (int u = tid; u < (LDS_BYTES - MISC_OFF) / 4; u += NTHREADS) ((LAS unsigned*)(lds + MISC_OFF))[u] = 0u;
    __syncthreads();
    const int lo = args.ph_lo, hi = args.ph_hi;
    const bool multi = (hi - lo) > 1;
    XcdBarrier bar; bar.bar = ctl + CW_BAR; bar.x = 0; bar.st = nullptr;
    if (multi) bar = xcd_barrier_post(ctl + CW_BAR, MISC + 8);
#ifndef PHMASK
#define PHMASK 0x1FFFF
#endif
#define IN(k) (((PHMASK >> (k)) & 1) && lo <= (k) && (k) < hi)
#define SEAM(k) do { if (IN(k) && IN((k) + 1)) xcd_barrier(bar); } while (0)

    if (IN(0)) {
        {
            const int idx = bx * 512 + tid;
            if (idx < D * NE) { const float w = w_router[idx]; const unsigned h = pk2(w, 0.f) & 0xffffu; const float r = w - __uint_as_float(h << 16); const unsigned l = pk2(r, 0.f) & 0xffffu;
                const int k = idx >> 5, e = idx & 31; WSP(unsigned short, WS_WRH)[e * D + k] = (unsigned short)h; WSP(unsigned short, WS_WRL)[e * D + k] = (unsigned short)l; }
            if (G * 512 < D * NE) for (int i2 = idx + G * 512; i2 < D * NE; i2 += G * 512) { const float w = w_router[i2]; const unsigned h = pk2(w, 0.f) & 0xffffu; const float r = w - __uint_as_float(h << 16); const unsigned l = pk2(r, 0.f) & 0xffffu;
                const int k = i2 >> 5, e = i2 & 31; WSP(unsigned short, WS_WRH)[e * D + k] = (unsigned short)h; WSP(unsigned short, WS_WRL)[e * D + k] = (unsigned short)l; }
        }
        {
            const int nnb0 = (DIN + 63) / 64;
            for (int it = gw; it < nnb0 * 32; it += NGW) transpose_item(w_in, DIN, NPROJ, 1, Win_t, it, nnb0, lane);
            for (int it = gw; it < 64 * 32; it += NGW) transpose_item(w_mem_kv, 2 * D, 2 * D, 0, Wkv_t, it, 64, lane);
            for (int it = gw; it < N_FP8_TILES * 8 * 16; it += NGW) transpose_item_fp8(w_in, DIN, N_FP8_TILES * 256, 3, ws_ + WS_GLOG + 32 * MiB, it, N_FP8_TILES * 8, lane, 256.0f);
        }
        {   LAS float* W1t = (LAS float*)lds;
            for (int idx = tid; idx < D * 4; idx += NTHREADS) { const int c = idx >> 2, q4 = idx & 3; const f32x4 w4 = *(const f32x4*)(w_in + (size_t)c * DIN + GA1_COL + 4 * q4);
                W1t[(4 * q4 + 0) * D + c] = w4[0]; W1t[(4 * q4 + 1) * D + c] = w4[1]; W1t[(4 * q4 + 2) * D + c] = w4[2]; W1t[(4 * q4 + 3) * D + c] = w4[3]; }
            __syncthreads();
            f32x4 vn[8];
            if (gw < T) {
#pragma unroll
                for (int j = 0; j < 8; ++j) vn[j] = *(const f32x4*)(x_in + (size_t)gw * D + 4 * lane + 256 * j); }
            for (int row = gw; row < T; row += NGW) {
                f32x4 v[8];
#pragma unroll
                for (int j = 0; j < 8; ++j) v[j] = vn[j];
                if (row + NGW < T) {
#pragma unroll
                    for (int j = 0; j < 8; ++j) vn[j] = *(const f32x4*)(x_in + (size_t)(row + NGW) * D + 4 * lane + 256 * j); }
                row_store_bf16(xb + (size_t)row * D, v, lane);
#pragma unroll
                for (int j = 0; j < 8; ++j) *(unsigned*)(ws_ + WS_GLOG + (size_t)row * D + 4 * lane + 256 * j) = pk4_fp8(v[j][0], v[j][1], v[j][2], v[j][3]);
                float mine = 0.f;
#pragma unroll 2
                for (int r16 = 0; r16 < 16; ++r16) { float p = 0.f;
#pragma unroll
                    for (int j = 0; j < 8; ++j) { const f32x4 w4 = *(const LAS f32x4*)(W1t + r16 * D + 4 * lane + 256 * j); p += (v[j][0] * w4[0] + v[j][1] * w4[1]) + (v[j][2] * w4[2] + v[j][3] * w4[3]); }
                    const float sum = wave_sum(p); if (lane == r16) mine = sum; }
                if (lane < 16) ga1[(size_t)row * 16 + lane] = mine + b_in[GA1_COL + lane];
            }
        }
        for (int row = gw; row < NBATCH * NMEM; row += NGW) {
            f32x4 v[8];
#pragma unroll
            for (int j = 0; j < 8; ++j) v[j] = *(const f32x4*)(mem_in + (size_t)row * D + 4 * lane + 256 * j);
            row_store_bf16(memb + (size_t)row * D, v, lane);
        }
        for (int i = bx * NTHREADS + tid; i < NPROJ; i += G * NTHREADS) binc[i] = b_in[i < GA1_COL ? i : i + 16];
        for (int i = bx * NTHREADS + tid; i < NE * 4096; i += G * NTHREADS) { const int e = i >> 12, n = i & 4095; bgup[e * 4096 + tmap(2, n)] = b_gate_up[i]; }
        for (int i = bx * NTHREADS + tid; i < D; i += G * NTHREADS) { const float l0 = lb_logits[i], l1 = lb_logits[D + i]; const float m = fmaxf(l0, l1); const float e0 = __expf(l0 - m), e1 = __expf(l1 - m); lbt[i] = e0 / (e0 + e1); }
    }
    SEAM(0);
    if (IN(1)) {
        {
            pg8::SchedSel S{(const char*)xb, (const char*)Win_t, T / 256, N_BF16_TILES, G, bx, (size_t)256 * D * 2, (size_t)256 * D * 2, 0};
            pg8::EpiBf16G E{proj, NPROJ, binc, 1.0f, 1.0f};
            pg8::gemm_phase<pg8::EpiBf16G, pg8::SchedSel, false>(lds, D, D, D, S, E); }
        {
            pg8::SchedSel S{(const char*)(ws_ + WS_GLOG), (const char*)(ws_ + WS_GLOG + 32 * MiB), T / 256, N_FP8_TILES, G, bx, (size_t)256 * D, (size_t)256 * D, 1};
            pg8::EpiBf16G E{proj, NPROJ, binc, 1.0f, 1.0f / 256.0f};
            pg8::gemm_phase<pg8::EpiBf16G, pg8::SchedSel, false, 1>(lds, D, D, D, S, E); }
    }
    SEAM(1);
    if (IN(3)) {
        {
            pg8::SchedKV S{(const char*)memb, (const char*)Wkv_t, G, bx};
            pg8::EpiKV E{kk, vt};
            pg8::gemm_phase<pg8::EpiKV, pg8::SchedKV, false>(lds, D, D, D, S, E);
        }
        {   PrepIn cur;
            if (bx < 1024) prep_load<0>(cur, tid, wave, proj, (bx >> 7) >> 2, (bx >> 7) & 3, bx & 127, 0);
            for (int u = bx; u < 1024; u += G) { const int pair = u >> 7, c = u & 127; const size_t pc = (size_t)pair * 128 + c; const int un = u + G; const bool hn = un < 1024;
                prep_unit<0>(lds, tid, pair >> 2, pair & 3, c, (un >> 7) >> 2, (un >> 7) & 3, un & 127, hn, cur, proj, ga1, w_a2, b_a, lbt, ws_ + WS_QFG + pc * 32768, ws_ + WS_KFG + pc * 32768, ws_ + WS_PFG + pc * 6144, (float*)(ws_ + WS_LAMG + pc * 1024), ws_ + WS_VFG + pc * 65536); }
            unsigned* hq = ctl + CW_HQ;
            if (tid == 0) MISC[40] = __hip_atomic_fetch_add(hq, 1u, RLX_AGENT);
            __syncthreads();
            int u = (int)MISC[40];
            if (u < 4096) prep_load<1>(cur, tid, wave, proj, (u >> 7) >> 4, (u >> 7) & 15, u & 127, 0);
            while (u < 4096) {
                __syncthreads();
                if (tid == 0) MISC[40] = __hip_atomic_fetch_add(hq, 1u, RLX_AGENT);
                __syncthreads();
                const int un = (int)MISC[40]; const bool hn = un < 4096;
                const int pair = u >> 7, c = u & 127; const size_t pc = (size_t)pair * 128 + c;
                prep_unit<1>(lds, tid, pair >> 4, pair & 15, c, (un >> 7) >> 4, (un >> 7) & 15, un & 127, hn, cur, proj, ga1, w_a2, b_a, lbt, ws_ + WS_QFH + pc * 16384, ws_ + WS_KFH + pc * 16384, ws_ + WS_PFH + pc * 6144, (float*)(ws_ + WS_LAMH + pc * 1024), ws_ + WS_VFH + pc * 16384);
                u = un;
            }
        }
    }
    SEAM(3);
    if (IN(4)) {
        const int NSCAN = 96; const bool split = G >= 192;
        volatile LAS unsigned* flg = MISC + 16;
        if (!(args.flags & 2) && (!split || bx < NSCAN)) {
            unsigned seq0 = 0u;
            for (int it = bx; it < NSCAN; it += (split ? NSCAN : G), seq0 += 128u) {
                if (it < 64) { const int pair = it & 7, e2 = it >> 3;
                    scan_item<0>(lds, flg, wave, lane, seq0, args.flags, ws_ + WS_QFG + (size_t)pair * 128 * 32768, ws_ + WS_KFG + (size_t)pair * 128 * 32768, ws_ + WS_PFG + (size_t)pair * 128 * 6144, ws_ + WS_LAMG + (size_t)pair * 128 * 1024,
                                 (const unsigned char*)(proj + (size_t)(pair >> 2) * SEQ * NPROJ + GV + (pair & 3) * 512 + e2 * 64), (bf16*)ogla + (size_t)(pair >> 2) * SEQ * D + (pair & 3) * 512 + e2 * 64);
                } else { const int pair = it - 64;
                    scan_item<1>(lds, flg, wave, lane, seq0, args.flags, ws_ + WS_QFH + (size_t)pair * 128 * 16384, ws_ + WS_KFH + (size_t)pair * 128 * 16384, ws_ + WS_PFH + (size_t)pair * 128 * 6144, ws_ + WS_LAMH + (size_t)pair * 128 * 1024,
                                 (const unsigned char*)(proj + (size_t)(pair >> 4) * SEQ * NPROJ + HI + (pair & 15) * 128), (bf16*)oh + (size_t)(pair >> 4) * SEQ * D + (pair & 15) * 128);
                }
            }
        }
        if (!(args.flags & 1) && (!split || bx >= NSCAN)) {
            if (!split) __syncthreads();
            constexpr int CWAVES = 8;
            if (split && wave >= CWAVES) {   } else {
            const int cw = split ? (bx - NSCAN) * CWAVES + wave : gw, NCW = split ? (G - NSCAN) * CWAVES : NGW;
            for (int it = cw; it < 32 * 32; it += NCW) transpose_item(w_mix_o, D, D, 0, Wo_t, it, 32, lane);
            for (int it = cw; it < 64 * 16; it += NCW) transpose_item_fp8(w_xq, D, D, 0, (unsigned char*)Wxq_t, it, 64, lane, 256.0f, ln1_g);
            for (int it = cw; it < 64 * 16; it += NCW) transpose_item_fp8(w_xo, D, D, 0, (unsigned char*)Wxo_t, it, 64, lane, 256.0f);
            for (int it = cw; it < 128 * 16 * NE; it += NCW) transpose_item_fp8(w_gate_up, 2 * D, 2 * D, 2, (unsigned char*)Wgu_t, it, 128, lane, 256.0f);
            for (int it = cw; it < 64 * 16 * NE; it += NCW) transpose_item_fp8(w_down, D, D, 0, (unsigned char*)Wd_t, it, 64, lane, 256.0f);
            }
        }
    }
    SEAM(4);
    if (IN(5)) {
        if (bx < 64) {
            const int cq = tid & 7, ks = tid >> 3;
            const float* src = w_xq + (size_t)ks * D + bx * 32 + 4 * cq;
            f32x4 s1 = {0.f, 0.f, 0.f, 0.f}, s2 = {0.f, 0.f, 0.f, 0.f};
#pragma unroll 8
            for (int i = 0; i < 32; ++i) { const f32x4 w = *(const f32x4*)(src + (size_t)64 * i * D); s1 += ln1_g[ks + 64 * i] * w; s2 += ln1_b[ks + 64 * i] * w; }
            LAS f32x4* red = (LAS f32x4*)lds;
            red[(ks * 8 + cq) * 2] = s1; red[(ks * 8 + cq) * 2 + 1] = s2;
            __syncthreads();
            if (tid < 64) { const int which = tid >> 5, col = tid & 31; float a = 0.f;
                for (int k2 = 0; k2 < 64; ++k2) a += ((LAS float*)lds)[((k2 * 8 + (col >> 2)) * 2 + which) * 4 + (col & 3)];
                WSP(float, WS_C12)[which * D + bx * 32 + col] = a; }
            __syncthreads();
        }
        for (int row = gw; row < T; row += NGW) {
            const bf16* pr = proj + (size_t)row * NPROJ;
            v4u aw[4], hw[4], grw[4], hgw[4], maw[4], mbw[4];
#pragma unroll
            for (int j2 = 0; j2 < 4; ++j2) { const int c = 8 * lane + 512 * j2; aw[j2] = *(const v4u*)((const bf16*)ogla + (size_t)row * D + c); hw[j2] = *(const v4u*)((const bf16*)oh + (size_t)row * D + c);
                grw[j2] = *(const v4u*)(pr + GR + c); hgw[j2] = *(const v4u*)(pr + HG + c); maw[j2] = *(const v4u*)(pr + MA + c); mbw[j2] = *(const v4u*)(pr + MB + c); }
#pragma unroll
            for (int j2 = 0; j2 < 4; ++j2) {
                int lo8 = 8 * lane; asm volatile("" : "+v"(lo8));
                const f32x4 gn0 = *(const f32x4*)(gla_g + lo8), gn1 = *(const f32x4*)(gla_g + lo8 + 4), hn0 = *(const f32x4*)(hgrn_g + (lo8 & 127)), hn1 = *(const f32x4*)(hgrn_g + (lo8 & 127) + 4);
                f32x4 a0, a1, h0, h1_, g0, g1, q0, q1, m0, m1, n0, n1;
                bf16x8_to_f32(aw[j2], a0, a1); bf16x8_to_f32(hw[j2], h0, h1_); bf16x8_to_f32(grw[j2], g0, g1); bf16x8_to_f32(hgw[j2], q0, q1); bf16x8_to_f32(maw[j2], m0, m1); bf16x8_to_f32(mbw[j2], n0, n1);
                float sg = ((a0[0] * a0[0] + a0[1] * a0[1]) + (a0[2] * a0[2] + a0[3] * a0[3])) + ((a1[0] * a1[0] + a1[1] * a1[1]) + (a1[2] * a1[2] + a1[3] * a1[3]));
                const float rg = __builtin_amdgcn_rsqf(wave_sum(sg) * (1.0f / 512.0f) + EPS);
                float sh = ((h0[0] * h0[0] + h0[1] * h0[1]) + (h0[2] * h0[2] + h0[3] * h0[3])) + ((h1_[0] * h1_[0] + h1_[1] * h1_[1]) + (h1_[2] * h1_[2] + h1_[3] * h1_[3]));
                sh += __shfl_xor(sh, 1); sh += __shfl_xor(sh, 2); sh += __shfl_xor(sh, 4); sh += __shfl_xor(sh, 8);
                const float rh = __builtin_amdgcn_rsqf(sh * (1.0f / 128.0f) + EPS);
                f32x4 o0, o1;
#pragma unroll
                for (int k = 0; k < 4; ++k) {
                    o0[k] = sigmoidf_(m0[k]) * (a0[k] * rg * gn0[k] * (g0[k] * sigmoidf_(g0[k]))) + sigmoidf_(n0[k]) * (h0[k] * rh * hn0[k] * sigmoidf_(q0[k]));
                    o1[k] = sigmoidf_(m1[k]) * (a1[k] * rg * gn1[k] * (g1[k] * sigmoidf_(g1[k]))) + sigmoidf_(n1[k]) * (h1_[k] * rh * hn1[k] * sigmoidf_(q1[k])); }
                v4u w; w.x = pk2(o0[0], o0[1]); w.y = pk2(o0[2], o0[3]); w.z = pk2(o1[0], o1[1]); w.w = pk2(o1[2], o1[3]);
                *(v4u*)(merged + (size_t)row * D + 8 * lane + 512 * j2) = w;
                if (j2 & 1) __builtin_amdgcn_sched_barrier(0);
            }
        }
    }
    SEAM(5);
    if (IN(6)) {
        pg8::SchedDense S{(const char*)merged, (const char*)Wo_t, T / 256, D / 256, G, bx, (size_t)256 * D * 2, (size_t)256 * D * 2};
        pg8::EpiPre1 E{(bf16*)pre1, (unsigned char*)h1, D, x_in, ALPHA, WSP(float, WS_STAT)};
        pg8::gemm_phase<pg8::EpiPre1, pg8::SchedDense, false>(lds, D, D, D, S, E);
    }
    SEAM(6);
    const bool own_chain = IN(8) && IN(9) && IN(11) && G == 256;
    if (IN(7) && !own_chain) {
        for (int row = bx * 512 + tid; row < T; row += G * 512) ln1_finish(WSP(float, WS_STAT), WSP(float, WS_FST), row);
    }
    if (!own_chain) SEAM(7);
    if (own_chain) {
        pg8::Unit u0; pg8::static_next(T / 256, XH, G, bx, 0, u0);
        const int opm = __builtin_amdgcn_readfirstlane(u0.pm), oh_ = __builtin_amdgcn_readfirstlane(u0.pn);
        if (tid < 256) ln1_finish(WSP(float, WS_STAT), WSP(float, WS_FST) + (size_t)oh_ * T * 2, opm * 256 + tid);
        __syncthreads();
        {   pg8::SchedOwn<pg8::SchedDense> S{{(const char*)h1, (const char*)Wxq_t, T / 256, D / 256, G, bx, (size_t)256 * D, (size_t)256 * D}, opm, 2 * oh_, 2};
            int oh2 = oh_; asm volatile("" : "+s"(oh2));
            pg8::EpiQFold E{qb, D, WSP(float, WS_FST) + (size_t)oh2 * T * 2, WSP(float, WS_C12), WSP(float, WS_C12) + D, 0.04419417382415922f, 1.0f / 256.0f};
            pg8::gemm_phase<pg8::EpiQFold, pg8::SchedOwn<pg8::SchedDense>, false, 1>(lds, D, D, D, S, E); }
        {   pg8::SchedOwn<pg8::SchedScores> S{{(const char*)qb, (const char*)kk, G, bx}, opm, oh_, 1};
            pg8::EpiSoftmax E{Pb, 1024, (LAS float*)(lds + RING_BYTES)};
            pg8::gemm_phase<pg8::EpiSoftmax, pg8::SchedOwn<pg8::SchedScores>, false>(lds, XDH, D, D, S, E); }
        {   pg8::SchedOwn<pg8::SchedPV> S{{(const char*)Pb, (const char*)vt, G, bx}, opm, 2 * oh_, 2};
            pg8::EpiFp8 E{(unsigned char*)ao, D, 16.0f};
            pg8::gemm_phase<pg8::EpiFp8, pg8::SchedOwn<pg8::SchedPV>, false>(lds, NMEM, 1024, 512, S, E); }
    } else {
    if (IN(8)) {
        pg8::SchedDense S{(const char*)h1, (const char*)Wxq_t, T / 256, D / 256, G, bx, (size_t)256 * D, (size_t)256 * D};
        pg8::EpiQFold E{qb, D, WSP(float, WS_FST), WSP(float, WS_C12), WSP(float, WS_C12) + D, 0.04419417382415922f, 1.0f / 256.0f};
        pg8::gemm_phase<pg8::EpiQFold, pg8::SchedDense, false, 1>(lds, D, D, D, S, E);
    }
    SEAM(8);
    if (IN(9)) {
        pg8::SchedScores S{(const char*)qb, (const char*)kk, G, bx};
        pg8::EpiSoftmax E{Pb, 1024, (LAS float*)(lds + RING_BYTES)};
        pg8::gemm_phase<pg8::EpiSoftmax, pg8::SchedScores, false>(lds, XDH, D, D, S, E);
    }
    if (IN(9) && IN(11)) xcd_barrier(bar);
    if (IN(11)) {
        pg8::SchedPV S{(const char*)Pb, (const char*)vt, G, bx};
        pg8::EpiFp8 E{(unsigned char*)ao, D, 16.0f};
        pg8::gemm_phase<pg8::EpiFp8, pg8::SchedPV, false>(lds, NMEM, 1024, 512, S, E);
    }
    }
    SEAM(11);
    if (IN(12)) {
        pg8::SchedDense S{(const char*)ao, (const char*)Wxo_t, T / 256, D / 256, G, bx, (size_t)256 * D, (size_t)256 * D};
        pg8::EpiXoFold E{(bf16*)pre2, D, (const bf16*)pre1, WSP(float, WS_FST), ln1_g, ln1_b, ALPHA, 1.0f / 4096.0f};
        pg8::gemm_phase<pg8::EpiXoFold, pg8::SchedDense, false, 1>(lds, D, D, D, S, E);
    }
    SEAM(12);
    if (IN(13)) {
        LAS int* lcnt = (LAS int*)(lds);
        LAS int* lbase = (LAS int*)(lds + 128);
        LAS int* lsel = (LAS int*)(lds + 256);
        constexpr int ARS = 4096 + 16;
        LAS unsigned char* AH = lds + 4096; LAS unsigned char* AL = lds + 4096 + 16 * ARS;
        LAS float* PART = (LAS float*)(lds + 4096 + 32 * ARS);
        const bool side = !(args.flags & 4);
#define ROUTER_LN(p_, q_) do { const int lr_ = 2 * wave + (q_); const int row_ = rb * 64 + (p_) * 16 + lr_; f32x4 v[8]; int lane_ = lane; asm volatile("" : "+v"(lane_));        \
            _Pragma("unroll") for (int j2 = 0; j2 < 4; ++j2) bf16x8_to_f32(raw[q_][j2], v[2 * j2], v[2 * j2 + 1]); float mu_, rs_; ln_apply_b_st(v, ln2_g, ln2_b, lane_, mu_, rs_); if (lane == 0) *(f32x2*)(WSP(float, WS_ST2) + 2 * (size_t)row_) = (f32x2){mu_, rs_}; \
            _Pragma("unroll") for (int j2 = 0; j2 < 4; ++j2) { const f32x4 a_ = v[2 * j2], b_ = v[2 * j2 + 1]; v4u hi_, lo_; \
                hi_.x = pk2(a_[0], a_[1]); hi_.y = pk2(a_[2], a_[3]); hi_.z = pk2(b_[0], b_[1]); hi_.w = pk2(b_[2], b_[3]); \
                lo_.x = pk2(a_[0] - __uint_as_float(hi_.x << 16), a_[1] - __uint_as_float(hi_.x & 0xffff0000u)); lo_.y = pk2(a_[2] - __uint_as_float(hi_.y << 16), a_[3] - __uint_as_float(hi_.y & 0xffff0000u)); \
                lo_.z = pk2(b_[0] - __uint_as_float(hi_.z << 16), b_[1] - __uint_as_float(hi_.z & 0xffff0000u)); lo_.w = pk2(b_[2] - __uint_as_float(hi_.w << 16), b_[3] - __uint_as_float(hi_.w & 0xffff0000u)); \
                v2u w8_; w8_.x = pk4_fp8(a_[0], a_[1], a_[2], a_[3]); w8_.y = pk4_fp8(b_[0], b_[1], b_[2], b_[3]); \
                *(v2u*)((unsigned char*)h2b + (size_t)row_ * D + 8 * lane_ + 512 * j2) = w8_; \
                *(LAS v4u*)(AH + lr_ * ARS + (8 * lane_ + 512 * j2) * 2) = hi_; *(LAS v4u*)(AL + lr_ * ARS + (8 * lane_ + 512 * j2) * 2) = lo_; } } while (0)
        const int fr = lane & 15, fq = lane >> 4;
        for (int rb = bx; rb < T / 64; rb += G) {
            if (tid < 32) lcnt[tid] = 0;
            v4u raw[2][4];
#define ROUTER_FETCH(p_) do { _Pragma("unroll") for (int q = 0; q < 2; ++q) _Pragma("unroll") for (int j2 = 0; j2 < 4; ++j2) \
                raw[q][j2] = *(const v4u*)((const bf16*)pre2 + (size_t)(rb * 64 + (p_) * 16 + 2 * wave + q) * D + 8 * lane + 512 * j2); } while (0)
            ROUTER_FETCH(0);
#pragma nounroll
            for (int ps = 0; ps < 4; ++ps) {
                bf16x8 bh0[4][2], bl0[4][2];
                unsigned boff = (unsigned)((fr * D + 256 * wave + 8 * fq) * 2); asm volatile("" : "+v"(boff));
#pragma unroll
                for (int ks = 0; ks < 4; ++ks)
#pragma unroll
                    for (int nt = 0; nt < 2; ++nt) { bh0[ks][nt] = *(const bf16x8*)((const char*)(WSP(bf16, WS_WRH) + nt * 16 * D) + boff + 64 * ks); bl0[ks][nt] = *(const bf16x8*)((const char*)(WSP(bf16, WS_WRL) + nt * 16 * D) + boff + 64 * ks); }
                ROUTER_LN(ps, 0);
                ROUTER_LN(ps, 1);
                if (ps + 1 < 4) ROUTER_FETCH(ps + 1);
                __syncthreads();
                {   bf16x8 bh1[4][2], bl1[4][2];
#pragma unroll
                    for (int ks = 0; ks < 4; ++ks)
#pragma unroll
                        for (int nt = 0; nt < 2; ++nt) { bh1[ks][nt] = *(const bf16x8*)((const char*)(WSP(bf16, WS_WRH) + nt * 16 * D) + boff + 64 * (ks + 4)); bl1[ks][nt] = *(const bf16x8*)((const char*)(WSP(bf16, WS_WRL) + nt * 16 * D) + boff + 64 * (ks + 4)); }
                    f32x4 acc[2] = {{0.f, 0.f, 0.f, 0.f}, {0.f, 0.f, 0.f, 0.f}};
                    const LAS unsigned char* ah = AH + fr * ARS + (256 * wave + 8 * fq) * 2; const LAS unsigned char* al = AL + fr * ARS + (256 * wave + 8 * fq) * 2;
#pragma unroll
                    for (int ks = 0; ks < 4; ++ks) { const bf16x8 xh = *(const LAS bf16x8*)(ah + 64 * ks), xl = *(const LAS bf16x8*)(al + 64 * ks);
#pragma unroll
                        for (int nt = 0; nt < 2; ++nt) { acc[nt] = __builtin_amdgcn_mfma_f32_16x16x32_bf16(bl0[ks][nt], xh, acc[nt], 0, 0, 0); acc[nt] = __builtin_amdgcn_mfma_f32_16x16x32_bf16(bh0[ks][nt], xl, acc[nt], 0, 0, 0);
                            acc[nt] = __builtin_amdgcn_mfma_f32_16x16x32_bf16(bh0[ks][nt], xh, acc[nt], 0, 0, 0); } }
#pragma unroll
                    for (int ks = 0; ks < 4; ++ks) { const bf16x8 xh = *(const LAS bf16x8*)(ah + 64 * (ks + 4)), xl = *(const LAS bf16x8*)(al + 64 * (ks + 4));
#pragma unroll
                        for (int nt = 0; nt < 2; ++nt) { acc[nt] = __builtin_amdgcn_mfma_f32_16x16x32_bf16(bl1[ks][nt], xh, acc[nt], 0, 0, 0); acc[nt] = __builtin_amdgcn_mfma_f32_16x16x32_bf16(bh1[ks][nt], xl, acc[nt], 0, 0, 0);
                            acc[nt] = __builtin_amdgcn_mfma_f32_16x16x32_bf16(bh1[ks][nt], xh, acc[nt], 0, 0, 0); } }
                    *(LAS f32x4*)(PART + (wave * 16 + fr) * 32 + 4 * fq) = acc[0]; *(LAS f32x4*)(PART + (wave * 16 + fr) * 32 + 16 + 4 * fq) = acc[1];
                }
                __syncthreads();
                {   const int hs = lane >> 5, lr = 2 * wave + hs, rr = ps * 16 + lr, row = rb * 64 + rr, e = lane & 31;
                    float lg = b_router[e];
#pragma unroll
                    for (int w8 = 0; w8 < 8; ++w8) lg += PART[(w8 * 16 + lr) * 32 + e];
                    float tl[4]; int te[4]; float val = lg;
#pragma unroll
                    for (int k = 0; k < 4; ++k) { float m = val; m = fmaxf(m, __shfl_xor(m, 1)); m = fmaxf(m, __shfl_xor(m, 2)); m = fmaxf(m, __shfl_xor(m, 4)); m = fmaxf(m, __shfl_xor(m, 8)); m = fmaxf(m, __shfl_xor(m, 16));
                        const unsigned long long bal = __ballot(val == m); const unsigned b32 = hs ? (unsigned)(bal >> 32) : (unsigned)bal; const int bi = (int)__builtin_ctz(b32) & 31;
                        tl[k] = m; te[k] = bi; if (e == bi) val = -3.0e38f; }
                    const float e1 = __expf(tl[1] - tl[0]), e2 = __expf(tl[2] - tl[0]), e3 = __expf(tl[3] - tl[0]); const float inv = 1.0f / (1.0f + e1 + e2 + e3);
                    if (e < 4) { const int ex = e == 0 ? te[0] : (e == 1 ? te[1] : (e == 2 ? te[2] : te[3])); const float gt = (e == 0 ? 1.0f : (e == 1 ? e1 : (e == 2 ? e2 : e3))) * inv;
                        gates[(size_t)row * 4 + e] = gt; if (side) { const int sl = __hip_atomic_fetch_add(&lcnt[ex], 1, __ATOMIC_RELAXED, __HIP_MEMORY_SCOPE_WORKGROUP); lsel[rr * 4 + e] = ex | (sl << 8); } }
                }
            }
            __syncthreads();
            if (tid < 32 && side) lbase[tid] = (int)atomicAdd(&ecnt[tid], (unsigned)lcnt[tid]);
            __syncthreads();
            if (tid < 256 && side) { const int s_ = lsel[tid]; const int e = s_ & 255, sl = s_ >> 8; list[e * MOE_CAP + lbase[e] + sl] = (rb * 64 + (tid >> 2)) * 4 + (tid & 3); }
            __syncthreads();
        }
    }
#undef ROUTER_LN
#undef ROUTER_FETCH
    SEAM(13);
    if (IN(14) || IN(15)) {
        LAS int* tab = (LAS int*)(lds + MOETAB_OFF);
        if (tid == 0) { int ts = 0; for (int e = 0; e < 32; ++e) { const int c = (int)__hip_atomic_load(&ecnt[e], RLX_AGENT); tab[e] = ts; tab[33 + e] = c; ts += (c + 255) >> 8; } tab[32] = ts; }
        __syncthreads();
        if (IN(14)) {
            LAS unsigned short* toks = (LAS unsigned short*)(lds + RING_BYTES);
            {
                pg8::SchedMoe S0{tab, nullptr, nullptr, list, 16, G, bx, 0, 1, nullptr};
                const int r_ = tid & 255, hsel = __builtin_amdgcn_readfirstlane(tid >> 8);
#pragma nounroll
                for (int i0 = 0; i0 < 32; i0 += 8) {
                    int av[4];
#pragma unroll
                    for (int k = 0; k < 4; ++k) { pg8::Unit u0; av[k] = -1; if (S0.next(i0 + 2 * k + hsel, u0)) { av[k] = 0; if (r_ < u0.rows) av[k] = list[u0.e * MOE_CAP + u0.mt * 256 + r_]; } }
#pragma unroll
                    for (int k = 0; k < 4; ++k) if (av[k] >= 0) toks[(i0 + 2 * k + hsel) * 256 + r_] = (unsigned short)(av[k] >> 2);
                    pg8::Unit u1; if (!S0.next(i0 + 8, u1)) break;
                }
                __syncthreads(); }
            pg8::SchedMoe S{tab, (const char*)h2b, (const char*)Wgu_t, list, 16, G, bx, (size_t)4096 * D, 1, G >= 160 ? toks : (LAS unsigned short*)nullptr};
            pg8::EpiSwiglu E{act, bgup, 1.0f / 256.0f};
            pg8::gemm_phase<pg8::EpiSwiglu, pg8::SchedMoe, true, 1>(lds, D, D, D, S, E);
        }
        SEAM(14);
        if (IN(15)) {
            LAS int* tA = (LAS int*)(lds + RING_BYTES); LAS float* tG = (LAS float*)(lds + RING_BYTES + 12 * 1024);
            const bool tok = G >= 216;
            if (tok) {
                pg8::SchedMoe S0{tab, nullptr, nullptr, list, 8, G, bx, 0, 1, nullptr};
                const int r_ = tid & 255, hsel = __builtin_amdgcn_readfirstlane(tid >> 8);
                int av[6]; float gv[6]; bool ok[6];
#pragma unroll
                for (int k = 0; k < 6; ++k) { pg8::Unit u0; av[k] = -1; ok[k] = S0.next(2 * k + hsel, u0); if (ok[k] && r_ < u0.rows) av[k] = list[u0.e * MOE_CAP + u0.mt * 256 + r_]; }
#pragma unroll
                for (int k = 0; k < 6; ++k) { gv[k] = 0.f; if (av[k] >= 0) gv[k] = gates[av[k]]; }
#pragma unroll
                for (int k = 0; k < 6; ++k) if (ok[k]) { tA[(2 * k + hsel) * 256 + r_] = av[k]; tG[(2 * k + hsel) * 256 + r_] = gv[k]; }
                __syncthreads(); }
            pg8::SchedMoe S{tab, (const char*)act, (const char*)Wd_t, nullptr, 8, G, bx, (size_t)D * D, 1, nullptr};
            pg8::EpiDown E{ybuf, b_down, list, gates, 1.0f / 256.0f, tok ? tA : (LAS int*)nullptr, tok ? tG : (LAS float*)nullptr};
            pg8::gemm_phase<pg8::EpiDown, pg8::SchedMoe, false, 1>(lds, D, D, D, S, E);
        }
    }
    SEAM(15);
    if (IN(16)) {
        v4u hw[4]; v2u yw[4][4]; f32x2 st2;
#define P16_FETCH(r_) do { _Pragma("unroll") for (int j2 = 0; j2 < 4; ++j2) { hw[j2] = *(const v4u*)((const bf16*)pre2 + (size_t)(r_) * D + 8 * lane + 512 * j2); \
            _Pragma("unroll") for (int k = 0; k < 4; ++k) yw[j2][k] = *(const v2u*)((const unsigned char*)ybuf + ((size_t)(r_) * 4 + k) * D + 8 * lane + 512 * j2); } \
            st2 = *(const f32x2*)(WSP(float, WS_ST2) + 2 * (size_t)(r_)); } while (0)
        if (gw < T) P16_FETCH(gw);
        for (int row = gw; row < T; row += NGW) {
            f32x4 v[8];
#pragma unroll
            for (int j2 = 0; j2 < 4; ++j2) { f32x4 a0, a1; bf16x8_to_f32(hw[j2], a0, a1);
                {
                    const f32x4 g0 = *(const f32x4*)(ln2_g + COLB(2 * j2)), g1 = *(const f32x4*)(ln2_g + COLB(2 * j2 + 1)), b0 = *(const f32x4*)(ln2_b + COLB(2 * j2)), b1 = *(const f32x4*)(ln2_b + COLB(2 * j2 + 1));
                    a0 = ((a0 - st2[0]) * st2[1] * g0 + b0) * ALPHA; a1 = ((a1 - st2[0]) * st2[1] * g1 + b1) * ALPHA; }
#pragma unroll
                for (int k = 0; k < 4; ++k) { const v2u w = yw[j2][k];
                    const f32x2 p0 = __builtin_amdgcn_cvt_pk_f32_fp8(w.x, false), p1 = __builtin_amdgcn_cvt_pk_f32_fp8(w.x, true), p2 = __builtin_amdgcn_cvt_pk_f32_fp8(w.y, false), p3 = __builtin_amdgcn_cvt_pk_f32_fp8(w.y, true);
                    a0 = a0 + (f32x4){p0[0], p0[1], p1[0], p1[1]} * 0.0625f; a1 = a1 + (f32x4){p2[0], p2[1], p3[0], p3[1]} * 0.0625f; }
                v[2 * j2] = a0; v[2 * j2 + 1] = a1; }
            if (row + NGW < T) P16_FETCH(row + NGW);
            ln_apply_b(v, ln3_g, ln3_b, lane);
#pragma unroll
            for (int j = 0; j < 8; ++j) __builtin_nontemporal_store(v[j], (f32x4*)(args.out + (size_t)row * D + COLB(j)));
        }
#undef P16_FETCH
    }
#undef IN
#undef SEAM
}
#undef x_in
#undef mem_in
#undef w_in
#undef b_in
#undef w_a2
#undef b_a
#undef gla_g
#undef hgrn_g
#undef lb_logits
#undef w_mix_o
#undef w_xq
#undef w_mem_kv
#undef w_xo
#undef w_router
#undef b_router
#undef w_gate_up
#undef b_gate_up
#undef w_down
#undef b_down
#undef ln1_g
#undef ln1_b
#undef ln2_g
#undef ln2_b
#undef ln3_g
#undef ln3_b
#undef Win_t
#undef Wo_t
#undef Wxq_t
#undef Wkv_t
#undef Wxo_t
#undef Wgu_t
#undef Wd_t
#undef xb
#undef memb
#undef ga1
#undef binc
#undef bgup
#undef lbt
#undef proj
#undef glog
#undef ogla
#undef oh
#undef merged
#undef pre1
#undef h1
#undef h1b
#undef qb
#undef kk
#undef vt
#undef sc
#undef Pb
#undef ao
#undef pre2
#undef h2
#undef h2b
#undef list
#undef gates
#undef act
#undef ybuf
#undef ecnt
#undef WSP
#undef ws_

extern "C" void kernel_launch(void* const* d_in, const int* in_sizes, int n_in, void* d_out, int out_size, void* d_ws, size_t ws_size, hipStream_t stream) {
    static int grid = 0;
    if (grid == 0) {
        if (n_in != 25 || out_size != T * D || ws_size < WS_END) { fprintf(stderr, "kernel_launch: unexpected problem: n_in %d out %d ws %zu (need %zu)\n", n_in, out_size, ws_size, (size_t)WS_END); grid = -1; return; }
        int dev = 0, cus = 0, per_cu = 0;
        if (hipGetDevice(&dev) != hipSuccess || hipDeviceGetAttribute(&cus, hipDeviceAttributeMultiprocessorCount, dev) != hipSuccess) { grid = -1; return; }
        if (hipFuncSetAttribute((const void*)fwd_kernel, hipFuncAttributeMaxDynamicSharedMemorySize, LDS_BYTES) != hipSuccess) { fprintf(stderr, "kernel_launch: hipFuncSetAttribute failed\n"); grid = -1; return; }
        if (hipOccupancyMaxActiveBlocksPerMultiprocessor(&per_cu, (const void*)fwd_kernel, NTHREADS, LDS_BYTES) != hipSuccess || per_cu < 1) { fprintf(stderr, "kernel_launch: occupancy query says %d\n", per_cu); }
        (void)hipGetLastError();
        grid = cus;
    }
    if (grid < 0) return;
    (void)hipMemsetAsync((char*)d_ws + WS_CTL, 0, CTL_ZERO_BYTES, stream);
    Args a{};
    for (int i = 0; i < 25; ++i) a.in[i] = (const float*)d_in[i];
    a.out = (float*)d_out; a.ws = (unsigned char*)d_ws;
#if MK_ONE_LAUNCH
    a.ph_lo = 0; a.ph_hi = N_PHASES;
    hipLaunchKernelGGL(fwd_kernel, dim3(grid), dim3(NTHREADS), LDS_BYTES, stream, a);
#ifdef PROBE_PHASE
    a.ph_lo = PROBE_PHASE; a.ph_hi = PROBE_PHASE + 1;
#ifdef PROBE_FLAGS
    a.flags = PROBE_FLAGS;
#endif
    hipLaunchKernelGGL(fwd_kernel, dim3(grid), dim3(NTHREADS), LDS_BYTES, stream, a);
#endif
#else
    for (int p = 0; p < N_PHASES; ++p) { a.ph_lo = p; a.ph_hi = p + 1; hipLaunchKernelGGL(fwd_kernel, dim3(grid), dim3(NTHREADS), LDS_BYTES, stream, a); }
#endif
}
```

```cpp
#include <hip/hip_runtime.h>
#include <cstdio>
#include <cstdint>

#ifndef MK_ONE_LAUNCH
#define MK_ONE_LAUNCH 1
#endif

#define GAS __attribute__((address_space(1)))
#define LAS __attribute__((address_space(3)))
typedef unsigned short bf16;
typedef unsigned v4u __attribute__((ext_vector_type(4)));
typedef unsigned v2u __attribute__((ext_vector_type(2)));
typedef float f32x4 __attribute__((ext_vector_type(4)));
typedef float f32x2 __attribute__((ext_vector_type(2)));
typedef short bf16x8 __attribute__((ext_vector_type(8)));
#define RLX_AGENT __ATOMIC_RELAXED, __HIP_MEMORY_SCOPE_AGENT
#define LDS_WAIT() asm volatile("s_waitcnt lgkmcnt(0)" ::: "memory")
#define VM_WAIT() asm volatile("s_waitcnt vmcnt(0)" ::: "memory")

constexpr int D = 2048, NBATCH = 2, SEQ = 8192, T = NBATCH * SEQ;
constexpr int DIN = 18448, NPROJ = 18432;
constexpr int GQ = 0, GK = 1024, GV = 2048, GR = 4096, HQ = 6144, HF = 8192, HI = 10240, HG = 12288, MA = 14336, MB = 16384;
constexpr int GA1_COL = 6144;
constexpr int NE = 32, TOPK = 4, NMEM = 256, XH = 4, XDH = 512;
constexpr int MOE_CAP = 16384, MOE_MAXTILES = 288;
constexpr float ALPHA = 1.189207115002721f;
constexpr float EPS = 1e-5f;
constexpr int NWAVES = 8, NTHREADS = 512;

#ifndef FP8_EXTRA
#define FP8_EXTRA 8, 9, 10, 11, 12, 13, 14, 15, 16, 17, 18, 19, 20, 21, 22, 23, 24, 25, 26, 27, 28, 29, 30, 31, 40, 41, 42, 43, 44, 45, 46, 47,
#endif
__device__ const unsigned char TILES_FP8[] = {FP8_EXTRA 32, 33, 34, 35, 36, 37, 38, 39, 48, 49, 50, 51, 52, 53, 54, 55, 56, 57, 58, 59, 60, 61, 62, 63, 64, 65, 66, 67, 68, 69, 70, 71};
constexpr int N_FP8_TILES = sizeof(TILES_FP8);
constexpr int N_BF16_TILES = 72 - N_FP8_TILES;
constexpr size_t MiB = 1u << 20;
constexpr size_t WS_CTL = 0, CTL_ZERO_BYTES = 1 * MiB;
constexpr size_t WS_WIN_T = 1 * MiB;
constexpr size_t WS_WO_T = WS_WIN_T + 72 * MiB;
constexpr size_t WS_WXQ_T = WS_WO_T + 8 * MiB;
constexpr size_t WS_WKV_T = WS_WXQ_T + 8 * MiB;
constexpr size_t WS_WXO_T = WS_WKV_T + 16 * MiB;
constexpr size_t WS_WGU_T = WS_WXO_T + 8 * MiB;
constexpr size_t WS_WD_T = WS_WGU_T + 512 * MiB;
constexpr size_t WS_XB = WS_WD_T + 256 * MiB;
constexpr size_t WS_MEMB = WS_XB + 64 * MiB;
constexpr size_t WS_GA1 = WS_MEMB + 2 * MiB;
constexpr size_t WS_BINC = WS_GA1 + 1 * MiB;
constexpr size_t WS_BGUP = WS_BINC + 1 * MiB;
constexpr size_t WS_LB = WS_BGUP + 1 * MiB;
constexpr size_t WS_PROJ = WS_LB + 1 * MiB;
constexpr size_t WS_GLOG = WS_PROJ + 576 * MiB;
constexpr size_t WS_OGLA = WS_GLOG + 64 * MiB;
constexpr size_t WS_OH = WS_OGLA + 128 * MiB;
constexpr size_t WS_MERGED = WS_OH + 128 * MiB;
constexpr size_t WS_PRE1 = WS_MERGED + 64 * MiB;
constexpr size_t WS_H1 = WS_PRE1 + 128 * MiB;
constexpr size_t WS_H1B = WS_H1 + 128 * MiB;
constexpr size_t WS_STAT = WS_H1 + 64 * MiB;
constexpr size_t WS_FST = WS_H1 + 72 * MiB;
constexpr size_t WS_WRH = WS_H1 + 88 * MiB;
constexpr size_t WS_WRL = WS_H1 + 89 * MiB;
constexpr size_t WS_ST2 = WS_H1 + 90 * MiB;
constexpr size_t WS_C12 = WS_H1 + 80 * MiB;
constexpr size_t WS_Q = WS_H1B + 64 * MiB;
constexpr size_t WS_KK = WS_Q + 64 * MiB;
constexpr size_t WS_VT = WS_KK + 2 * MiB;
constexpr size_t WS_SC = WS_VT + 2 * MiB;
constexpr size_t WS_P = WS_SC + 64 * MiB;
constexpr size_t WS_AO = WS_P + 32 * MiB;
constexpr size_t WS_PRE2 = WS_AO + 64 * MiB;
constexpr size_t WS_H2 = WS_PRE2 + 128 * MiB;
constexpr size_t WS_H2B = WS_H2 + 128 * MiB;
constexpr size_t WS_LIST = WS_H2B + 64 * MiB;
constexpr size_t WS_GATES = WS_LIST + 2 * MiB;
constexpr size_t WS_ACT = WS_GATES + 1 * MiB;
constexpr size_t WS_YBUF = WS_ACT + 288 * MiB;
constexpr size_t WS_QFG = WS_YBUF + 256 * MiB;
constexpr size_t WS_KFG = WS_QFG + 32 * MiB;
constexpr size_t WS_PFG = WS_KFG + 32 * MiB;
constexpr size_t WS_LAMG = WS_PFG + 6 * MiB;
constexpr size_t WS_VFG = WS_LAMG + 1 * MiB;
constexpr size_t WS_QFH = WS_VFG + 64 * MiB;
constexpr size_t WS_KFH = WS_QFH + 64 * MiB;
constexpr size_t WS_PFH = WS_KFH + 64 * MiB;
constexpr size_t WS_LAMH = WS_PFH + 24 * MiB;
constexpr size_t WS_VFH = WS_LAMH + 4 * MiB;
constexpr size_t WS_END = WS_VFH + 64 * MiB + 1 * MiB;
constexpr int CW_TMO = 0;
constexpr int CW_CNT = 64;
constexpr int CW_HQ = 256;
constexpr int CW_BAR = 4096;

constexpr int RING_BYTES = 131072;
constexpr int LDS_BYTES = 163840;
constexpr int MISC_OFF = LDS_BYTES - 1024;
constexpr int MOETAB_OFF = MISC_OFF + 256;
constexpr int SCAN_STAGE = 76800;
static_assert(2 * SCAN_STAGE <= MISC_OFF, "scan stages below the control words");

__device__ __forceinline__ float bf2f(unsigned b) { return __uint_as_float(b << 16); }
__device__ __forceinline__ unsigned f2bf(float f) { unsigned u = __float_as_uint(f); return (u + 0x7fffu + ((u >> 16) & 1u)) >> 16; }
typedef __bf16 bf16x2_hw __attribute__((ext_vector_type(2)));
__device__ __forceinline__ unsigned pk2(float lo, float hi) { f32x2 v = {lo, hi}; return __builtin_bit_cast(unsigned, __builtin_convertvector(v, bf16x2_hw)); }
__device__ __forceinline__ float sigmoidf_(float x) { return __builtin_amdgcn_rcpf(1.0f + __expf(-x)); }
__device__ __forceinline__ float logsigmoidf_(float z) { return z < 0.f ? z - log1pf(__expf(z)) : -log1pf(__expf(-z)); }
__device__ __forceinline__ float wave_sum(float v) {
#pragma unroll
    for (int o = 1; o < 64; o <<= 1) v += __shfl_xor(v, o);
    return v;
}
__device__ __forceinline__ float wave_max(float v) {
#pragma unroll
    for (int o = 1; o < 64; o <<= 1) v = fmaxf(v, __shfl_xor(v, o));
    return v;
}

namespace pg8 {
constexpr int BM = 256, BK = 64, HALF = 128, HTB = HALF * BK * 2, STAGE_BYTES = 8 * HTB, NXCD = 8, WGM = 8;
__host__ __device__ __forceinline__ int lds_byte(int r, int c) { const int st = (r >> 4) * 2 + (c >> 5), rr = r & 15, cc = c & 31, ob = rr * 64 + cc * 2; return st * 1024 + (ob ^ (((ob >> 9) & 1) << 5)); }
__host__ __device__ __forceinline__ void stage_rc(int b, int& R, int& C) { const int st = b / 1024, sb = b % 1024, swz = sb ^ (((sb >> 9) & 1) << 5); R = (st >> 1) * 16 + swz / 64; C = (st & 1) * 32 + (swz % 64) / 2; }
__host__ __device__ __forceinline__ int perm32(int rho) { const int n = rho >> 4, i = rho & 15; return 8 * (i >> 2) + 4 * n + (i & 3); }

struct Unit { int pm, pn, e, mt, rows, idx; };

__device__ __forceinline__ bool static_next(int nM, int nN, int G, int c, int i, Unit& u) {
    const int nwg = nM * nN; const long L = (long)i * G + c; if (L >= nwg) return false;
    int wgid = (int)L; { const int q = nwg / NXCD, r = nwg % NXCD, xcd = wgid % NXCD, off = wgid / NXCD; wgid = (xcd < r ? xcd * (q + 1) : r * (q + 1) + (xcd - r) * q) + off; }
    const int nig = WGM * nN, gid = wgid / nig, fm = gid * WGM, gsz = (nM - fm) < WGM ? (nM - fm) : WGM;
    u.pm = fm + ((wgid % nig) % gsz); u.pn = (wgid % nig) / gsz; u.e = 0; u.mt = 0; u.rows = 256; u.idx = i; return true;
}

__device__ __forceinline__ unsigned cvt_pk_bf16(float lo, float hi) { unsigned r; asm volatile("v_cvt_pk_bf16_f32 %0, %1, %2" : "=v"(r) : "v"(lo), "v"(hi)); return r; }

typedef f32x4 Acc[2][2][4][2];

typedef int i32x4_t __attribute__((ext_vector_type(4)));
typedef int i32x8_t __attribute__((ext_vector_type(8)));
__device__ __forceinline__ i32x8_t cat8(bf16x8 a, bf16x8 b) { return __builtin_shufflevector(__builtin_bit_cast(i32x4_t, a), __builtin_bit_cast(i32x4_t, b), 0, 1, 2, 3, 4, 5, 6, 7); }
template <class Epi, class Sched, bool GATHER, int ESZ = 2>
__device__ __forceinline__ void gemm_phase(LAS unsigned char* lds, const int K, const int lda, const int ldb, const Sched& S, const Epi& E) {
    int tid_ = threadIdx.x; asm volatile("" : "+v"(tid_));
    const int tid = tid_, wid = __builtin_amdgcn_readfirstlane(tid >> 6), lane = tid & 63, wr = wid >> 2, wc = wid & 3, fr = lane & 15, fq = lane >> 4;
    const int nt = K * ESZ / 128;
    unsigned voffA[2], voffB[2]; int RA[2]; unsigned CA2[2];
#pragma unroll
    for (int i = 0; i < 2; ++i) { int R, C; stage_rc(tid * 16 + i * 8192, R, C); const int Rb = Epi::PERM ? ((R & ~31) + perm32(R & 31)) : R;
        voffA[i] = (unsigned)(R * lda * ESZ + C * 2); voffB[i] = (unsigned)(Rb * ldb * ESZ + C * 2); RA[i] = R; CA2[i] = (unsigned)C * 2u; }
    const size_t kstep = (size_t)(BK * 2);
    const size_t hstepA = (size_t)HALF * lda * ESZ, hstepB = (size_t)HALF * ldb * ESZ;
    const unsigned ldsw = (unsigned)wid * 1024u;
    const int aoff = lds_byte(wr * 64 + fr, fq * 8), boff = lds_byte(wc * 32 + fr, fq * 8);
#define PG8_SA(b, h) (((b) * 2 + (h)) * HTB)
#define PG8_SB(b, h) ((4 + (b) * 2 + (h)) * HTB)
#define PG8_STAGE_RAW(bufoff, gptr, o0, o1) do { \
        __builtin_amdgcn_global_load_lds((const unsigned*)((const char*)(gptr) + (o0)), (LAS unsigned*)(lds + (bufoff) + ldsw), 16, 0, 0); \
        __builtin_amdgcn_global_load_lds((const unsigned*)((const char*)(gptr) + (o1)), (LAS unsigned*)(lds + (bufoff) + ldsw + 8192), 16, 0, 0); } while (0)
#define PG8_STAGE_B(bufoff, gptr) PG8_STAGE_RAW(bufoff, gptr, voffB[0], voffB[1])
#define PG8_STAGE_A_CUR(bufoff, kptr, half) do { if constexpr (GATHER) { if ((half) == 0) PG8_STAGE_RAW(bufoff, kptr, vAc0[0], vAc0[1]); else PG8_STAGE_RAW(bufoff, kptr, vAc1[0], vAc1[1]); } \
        else { PG8_STAGE_RAW(bufoff, (kptr) + (half) * hstepA, voffA[0], voffA[1]); } } while (0)
#define PG8_STAGE_A_SEL(bufoff, kptr, half) do { if constexpr (GATHER) { if ((half) == 0) PG8_STAGE_RAW(bufoff, kptr, (last ? vAn0[0] : vAc0[0]), (last ? vAn0[1] : vAc0[1])); else PG8_STAGE_RAW(bufoff, kptr, (last ? vAn1[0] : vAc1[0]), (last ? vAn1[1] : vAc1[1])); } \
        else { PG8_STAGE_RAW(bufoff, (kptr) + (half) * hstepA, voffA[0], voffA[1]); } } while (0)
#define PG8_LDA(dst, b, h) do { _Pragma("unroll") for (int m = 0; m < 4; ++m) { const i32x4_t lo_ = *(const LAS i32x4_t*)(lds + PG8_SA(b, h) + aoff + m * 2048), hi_ = *(const LAS i32x4_t*)(lds + PG8_SA(b, h) + aoff + m * 2048 + 1024); dst[m] = __builtin_shufflevector(lo_, hi_, 0, 1, 2, 3, 4, 5, 6, 7); } } while (0)
#define PG8_LDB(dst, b, h) do { _Pragma("unroll") for (int n = 0; n < 2; ++n) { const i32x4_t lo_ = *(const LAS i32x4_t*)(lds + PG8_SB(b, h) + boff + n * 2048), hi_ = *(const LAS i32x4_t*)(lds + PG8_SB(b, h) + boff + n * 2048 + 1024); dst[n] = __builtin_shufflevector(lo_, hi_, 0, 1, 2, 3, 4, 5, 6, 7); } } while (0)
#define PG8_LO(x) __builtin_bit_cast(bf16x8, __builtin_shufflevector(x, x, 0, 1, 2, 3))
#define PG8_HI(x) __builtin_bit_cast(bf16x8, __builtin_shufflevector(x, x, 4, 5, 6, 7))
#define PG8_MMA(ai, bj, At, Bt) do { __builtin_amdgcn_s_setprio(1); if constexpr (ESZ == 2) { _Pragma("unroll") for (int m = 0; m < 4; ++m) _Pragma("unroll") for (int n = 0; n < 2; ++n) { \
        acc[ai][bj][m][n] = __builtin_amdgcn_mfma_f32_16x16x32_bf16(PG8_LO(Bt[n]), PG8_LO(At[m]), acc[ai][bj][m][n], 0, 0, 0); acc[ai][bj][m][n] = __builtin_amdgcn_mfma_f32_16x16x32_bf16(PG8_HI(Bt[n]), PG8_HI(At[m]), acc[ai][bj][m][n], 0, 0, 0); } } \
        else { _Pragma("unroll") for (int m = 0; m < 4; ++m) _Pragma("unroll") for (int n = 0; n < 2; ++n) \
        asm volatile("v_mfma_scale_f32_16x16x128_f8f6f4 %0, %1, %2, %0, %3, %3 op_sel_hi:[0,0,0]" : "+v"(acc[ai][bj][m][n]) : "v"(Bt[n]), "v"(At[m]), "v"(mx_one)); } __builtin_amdgcn_s_setprio(0); } while (0)
#define PG8_WAIT_V(n) asm volatile("s_waitcnt vmcnt(" #n ")" ::: "memory")
#define PG8_WAIT_L(n) asm volatile("s_waitcnt lgkmcnt(" #n ")" ::: "memory")
#define PG8_BAR __builtin_amdgcn_s_barrier()
#define PG8_SCHED __builtin_amdgcn_sched_barrier(0)
    Unit cur, nxt; int ui = 0;
    if (!S.next(0, cur)) return;
    Acc acc;
#pragma unroll
    for (int a = 0; a < 2; ++a)
#pragma unroll
        for (int b = 0; b < 2; ++b)
#pragma unroll
            for (int m = 0; m < 4; ++m)
#pragma unroll
                for (int n = 0; n < 2; ++n) acc[a][b][m][n] = (f32x4){0.f, 0.f, 0.f, 0.f};
    i32x8_t At[4], B0[2], B1[2];
    const int mx_one = 0x7F7F7F7F;
    const char* cA = S.a_base(cur); const char* cB = S.b_base(cur);
    unsigned vAc0[2] = {0u, 0u}, vAc1[2] = {0u, 0u}, vAn0[2] = {0u, 0u}, vAn1[2] = {0u, 0u};
    if constexpr (GATHER) {
#pragma unroll
        for (int i = 0; i < 2; ++i) { vAc0[i] = S.row_off(cur, RA[i]) + CA2[i]; vAc1[i] = S.row_off(cur, HALF + RA[i]) + CA2[i]; }
    }
    PG8_STAGE_B(PG8_SB(0, 0), cB); PG8_STAGE_B(PG8_SB(0, 1), cB + hstepB); PG8_STAGE_A_CUR(PG8_SA(0, 0), cA, 0); PG8_STAGE_A_CUR(PG8_SA(0, 1), cA, 1);
    if (wr == 1) PG8_BAR;
    PG8_WAIT_V(2); PG8_BAR;
    PG8_STAGE_B(PG8_SB(1, 0), cB + kstep); PG8_STAGE_A_CUR(PG8_SA(1, 0), cA + kstep, 0); PG8_STAGE_B(PG8_SB(1, 1), cB + hstepB + kstep);
    PG8_WAIT_V(6); PG8_BAR;
    for (;;) {
        const bool has_next = S.next(ui + 1, nxt);
        const char* nA = has_next ? S.a_base(nxt) : cA; const char* nB = has_next ? S.b_base(nxt) : cB;
        if constexpr (GATHER) {
            if (has_next) {
#pragma unroll
                for (int i = 0; i < 2; ++i) { vAn0[i] = S.row_off(nxt, RA[i]) + CA2[i]; vAn1[i] = S.row_off(nxt, HALF + RA[i]) + CA2[i]; }
            } else {
#pragma unroll
                for (int i = 0; i < 2; ++i) { vAn0[i] = vAc0[i]; vAn1[i] = vAc1[i]; }
            }
        }
#pragma nounroll
        for (int t = 0; t < nt; t += 2) {
            const bool last = (t == nt - 2);
            const char* a1 = cA + (size_t)(t + 1) * kstep;
            const char* a2 = last ? nA : cA + (size_t)(t + 2) * kstep; const char* b2 = last ? nB : cB + (size_t)(t + 2) * kstep;
            const char* a3 = a2 + kstep; const char* b3 = b2 + kstep;
            PG8_LDB(B0, 0, 0); PG8_LDB(B1, 0, 1); PG8_SCHED; PG8_LDA(At, 0, 0); PG8_STAGE_A_CUR(PG8_SA(1, 1), a1, 1);
            PG8_WAIT_V(8); PG8_WAIT_L(0); PG8_BAR; PG8_MMA(0, 0, At, B0); PG8_MMA(0, 1, At, B1); PG8_BAR; PG8_SCHED;
            PG8_LDA(At, 0, 1); PG8_STAGE_B(PG8_SB(0, 0), b2); PG8_STAGE_B(PG8_SB(0, 1), b2 + hstepB); PG8_STAGE_A_SEL(PG8_SA(0, 0), a2, 0);
            PG8_WAIT_V(8); PG8_WAIT_L(0); PG8_BAR; if (!(Sched::HALF_SKIP && cur.rows <= HALF)) { PG8_MMA(1, 0, At, B0); PG8_MMA(1, 1, At, B1); } PG8_BAR; PG8_SCHED;
            PG8_LDB(B0, 1, 0); PG8_LDB(B1, 1, 1); PG8_SCHED; PG8_LDA(At, 1, 0); PG8_STAGE_A_SEL(PG8_SA(0, 1), a2, 1);
            PG8_WAIT_V(8); PG8_WAIT_L(0); PG8_BAR; PG8_MMA(0, 0, At, B0); PG8_MMA(0, 1, At, B1); PG8_BAR; PG8_SCHED;
            PG8_LDA(At, 1, 1); PG8_STAGE_B(PG8_SB(1, 0), b3); PG8_STAGE_B(PG8_SB(1, 1), b3 + hstepB); PG8_STAGE_A_SEL(PG8_SA(1, 0), a3, 0);
            PG8_WAIT_V(8); PG8_WAIT_L(0); PG8_BAR; if (!(Sched::HALF_SKIP && cur.rows <= HALF)) { PG8_MMA(1, 0, At, B0); PG8_MMA(1, 1, At, B1); } PG8_BAR; PG8_SCHED;
        }
        if (wr == 0) PG8_BAR;
        if constexpr (ESZ == 1) asm volatile("s_nop 15\n\ts_nop 15" ::: "memory");
        E(acc, cur, wr, wc, fr, fq);
        if (!has_next) break;
#pragma unroll
        for (int a = 0; a < 2; ++a)
#pragma unroll
            for (int b = 0; b < 2; ++b)
#pragma unroll
                for (int m = 0; m < 4; ++m)
#pragma unroll
                    for (int n = 0; n < 2; ++n) acc[a][b][m][n] = (f32x4){0.f, 0.f, 0.f, 0.f};
        cur = nxt; cA = nA; cB = nB; ++ui;
        if constexpr (GATHER) {
#pragma unroll
            for (int i = 0; i < 2; ++i) { vAc0[i] = vAn0[i]; vAc1[i] = vAn1[i]; }
        }
        if (wr == 1) PG8_BAR;
    }
    PG8_WAIT_V(0);
    PG8_BAR;
#undef PG8_SA
#undef PG8_SB
#undef PG8_STAGE_RAW
#undef PG8_STAGE_B
#undef PG8_STAGE_A_CUR
#undef PG8_STAGE_A_SEL
#undef PG8_LDA
#undef PG8_LDB
#undef PG8_MMA
#undef PG8_LO
#undef PG8_HI
#undef PG8_WAIT_V
#undef PG8_WAIT_L
#undef PG8_BAR
#undef PG8_SCHED
}

struct SchedDense {
    static constexpr bool HALF_SKIP = false;
    const char* A; const char* Bt; int nM, nN, G, c; size_t astep, bstep;
    __device__ __forceinline__ bool next(int i, Unit& u) const { return static_next(nM, nN, G, c, i, u); }
    __device__ __forceinline__ const char* a_base(const Unit& u) const { return A + (size_t)u.pm * astep; }
    __device__ __forceinline__ const char* b_base(const Unit& u) const { return Bt + (size_t)u.pn * bstep; }
    __device__ __forceinline__ unsigned row_off(const Unit&, int) const { return 0u; }
};
struct SchedSel {
    static constexpr bool HALF_SKIP = false;
    const char* A; const char* Bt; int nM, nSel, G, c; size_t astep, bstep; int fp8;
    __device__ __forceinline__ bool next(int i, Unit& u) const { if (!static_next(nM, nSel, G, c, i, u)) return false; u.e = u.pn;
        if (fp8) u.pn = TILES_FP8[u.e];
        else { int t = 0, k = -1; for (; t < 72; ++t) { bool in = false; for (int q = 0; q < N_FP8_TILES; ++q) in |= (TILES_FP8[q] == t); if (!in && ++k == u.e) break; } u.pn = t; }
        return true; }
    __device__ __forceinline__ const char* a_base(const Unit& u) const { return A + (size_t)u.pm * astep; }
    __device__ __forceinline__ const char* b_base(const Unit& u) const { return Bt + (size_t)(fp8 ? u.e : u.pn) * bstep; }
    __device__ __forceinline__ unsigned row_off(const Unit&, int) const { return 0u; }
};
struct SchedKV {
    static constexpr bool HALF_SKIP = false;
    const char* memb; const char* wkv; int G, c;
    __device__ __forceinline__ bool next(int i, Unit& u) const {
        const int L = i * G + c; if (L >= 32) return false;
        if (L < 16) { u.e = 0; u.pm = L & 1; u.pn = L >> 1; } else { const int l = L - 16; u.e = 1; u.pm = l >> 1; u.pn = l & 1; }
        u.mt = 0; u.rows = 256; u.idx = i; return true; }
    __device__ __forceinline__ const char* a_base(const Unit& u) const { return u.e == 0 ? memb + (size_t)u.pm * 256 * D * 2 : wkv + (size_t)(2048 + u.pm * 256) * D * 2; }
    __device__ __forceinline__ const char* b_base(const Unit& u) const { return u.e == 0 ? wkv + (size_t)u.pn * 256 * D * 2 : memb + (size_t)u.pn * 256 * D * 2; }
    __device__ __forceinline__ unsigned row_off(const Unit&, int) const { return 0u; }
};
struct SchedScores {
    static constexpr bool HALF_SKIP = false;
    const char* q; const char* kk; int G, c;
    __device__ __forceinline__ bool next(int i, Unit& u) const { return static_next(T / 256, XH, G, c, i, u); }
    __device__ __forceinline__ const char* a_base(const Unit& u) const { return q + ((size_t)u.pm * 256 * D + (size_t)u.pn * XDH) * 2; }
    __device__ __forceinline__ const char* b_base(const Unit& u) const { return kk + ((size_t)(u.pm / 32) * NMEM * D + (size_t)u.pn * XDH) * 2; }
    __device__ __forceinline__ unsigned row_off(const Unit&, int) const { return 0u; }
};
struct SchedPV {
    static constexpr bool HALF_SKIP = false;
    const char* P; const char* vt; int G, c;
    __device__ __forceinline__ bool next(int i, Unit& u) const { return static_next(T / 256, D / 256, G, c, i, u); }
    __device__ __forceinline__ const char* a_base(const Unit& u) const { return P + ((size_t)u.pm * 256 * 1024 + (size_t)(u.pn >> 1) * 256) * 2; }
    __device__ __forceinline__ const char* b_base(const Unit& u) const { return vt + ((size_t)u.pn * 256 * 512 + (size_t)(u.pm / 32) * NMEM) * 2; }
    __device__ __forceinline__ unsigned row_off(const Unit&, int) const { return 0u; }
};
template <class Base> struct SchedOwn : Base {
    int opm, opn0, on;
    __device__ __forceinline__ bool next(int i, Unit& u) const { if (i >= on) return false; u.pm = opm; u.pn = opn0 + i; u.e = 0; u.mt = 0; u.rows = 256; u.idx = i; return true; }
};
struct SchedMoe {
    static constexpr bool HALF_SKIP = true;
    const LAS int* tab; const char* A; const char* Bt; const int* list; int nN, G, c; size_t b_estride; int esz; const LAS unsigned short* toks;
    __device__ __forceinline__ int tb(int i) const { return __builtin_amdgcn_readfirstlane(tab[i]); }
    __device__ __forceinline__ bool next(int i, Unit& u) const {
        const int TM = tb(32), nwg = TM * nN; const long L = (long)i * G + c; if (L >= nwg) return false;
        int wgid = (int)L; { const int q = nwg / NXCD, r = nwg % NXCD, xcd = wgid % NXCD, off = wgid / NXCD; wgid = (xcd < r ? xcd * (q + 1) : r * (q + 1) + (xcd - r) * q) + off; }
        int lo = 0, hi = 31;
        while (lo < hi) { const int mid = (lo + hi) >> 1; if (wgid < tb(mid + 1) * nN) hi = mid; else lo = mid + 1; }
        const int e = lo, ts = tb(e), te = tb(e + 1) - ts, idx = wgid - ts * nN, cnt = tb(33 + e);
        u.e = e; u.pn = idx / te; u.mt = idx % te; u.pm = ts + u.mt; const int rem = cnt - u.mt * 256; u.rows = rem < 256 ? rem : 256; u.idx = i; return true; }
    __device__ __forceinline__ const char* a_base(const Unit& u) const { return A + (list ? (size_t)0 : (size_t)u.pm * 256 * D * esz); }
    __device__ __forceinline__ const char* b_base(const Unit& u) const { return Bt + (size_t)u.e * b_estride + (size_t)u.pn * 256 * D * esz; }
    __device__ __forceinline__ unsigned row_off(const Unit& u, int r) const {
        if (toks) return (unsigned)toks[u.idx * 256 + r] * (unsigned)(D * esz);
        int a = 0; if (r < u.rows) a = list[u.e * MOE_CAP + u.mt * 256 + r];
        return (unsigned)(a >> 2) * (unsigned)(D * esz); }
};

struct EpiBf16G {
    static constexpr bool PERM = true;
    bf16* O; int ldc; const float* bias; float scale; float ascale;
    __device__ __forceinline__ void operator()(const Acc& acc, const Unit& u, int wr, int wc, int fr, int fq) const {
        const int row0 = u.pm * BM + wr * 64 + fr, col0 = u.pn * BM + wc * 32 + 8 * fq;
        f32x4 bv[2][2];
#pragma unroll
        for (int bj = 0; bj < 2; ++bj)
#pragma unroll
            for (int n = 0; n < 2; ++n) bv[bj][n] = bias ? *(const f32x4*)(bias + col0 + bj * HALF + 4 * n) : (f32x4){0.f, 0.f, 0.f, 0.f};
#pragma unroll
        for (int ai = 0; ai < 2; ++ai)
#pragma unroll
            for (int m = 0; m < 4; ++m) { bf16* rowp = O + (size_t)(row0 + ai * HALF + m * 16) * ldc + col0;
#pragma unroll
                for (int bj = 0; bj < 2; ++bj) { f32x4 v0 = (acc[ai][bj][m][0] * ascale + bv[bj][0]) * scale, v1 = (acc[ai][bj][m][1] * ascale + bv[bj][1]) * scale;
                    v4u w; w.x = cvt_pk_bf16(v0[0], v0[1]); w.y = cvt_pk_bf16(v0[2], v0[3]); w.z = cvt_pk_bf16(v1[0], v1[1]); w.w = cvt_pk_bf16(v1[2], v1[3]);
                    *(v4u*)(rowp + bj * HALF) = w; } }
    }
};
struct EpiKV {
    static constexpr bool PERM = true;
    bf16* kk; bf16* vt;
    __device__ __forceinline__ void operator()(const Acc& acc, const Unit& u, int wr, int wc, int fr, int fq) const {
        bf16* O = u.e == 0 ? kk : vt; const int ldc = u.e == 0 ? D : 512;
        const int row0 = u.pm * BM + wr * 64 + fr, col0 = u.pn * BM + wc * 32 + 8 * fq;
#pragma unroll
        for (int ai = 0; ai < 2; ++ai)
#pragma unroll
            for (int m = 0; m < 4; ++m) { bf16* rowp = O + (size_t)(row0 + ai * HALF + m * 16) * ldc + col0;
#pragma unroll
                for (int bj = 0; bj < 2; ++bj) { const f32x4 v0 = acc[ai][bj][m][0], v1 = acc[ai][bj][m][1];
                    v4u w; w.x = cvt_pk_bf16(v0[0], v0[1]); w.y = cvt_pk_bf16(v0[2], v0[3]); w.z = cvt_pk_bf16(v1[0], v1[1]); w.w = cvt_pk_bf16(v1[2], v1[3]);
                    *(v4u*)(rowp + bj * HALF) = w; } }
    }
};
struct EpiF32Res {
    static constexpr bool PERM = false;
    float* C; int ldc; const float* res; float rs;
    __device__ __forceinline__ void operator()(const Acc& acc, const Unit& u, int wr, int wc, int fr, int fq) const {
        const int row0 = u.pm * BM + wr * 64 + fr, col0 = u.pn * BM + wc * 32 + 4 * fq;
#pragma unroll
        for (int ai = 0; ai < 2; ++ai)
#pragma unroll
            for (int m = 0; m < 4; ++m) { const size_t ro = (size_t)(row0 + ai * HALF + m * 16) * ldc + col0;
#pragma unroll
                for (int bj = 0; bj < 2; ++bj)
#pragma unroll
                    for (int n = 0; n < 2; ++n) { f32x4 v = acc[ai][bj][m][n]; if (res) v = v + rs * *(const f32x4*)(res + ro + bj * HALF + n * 16); *(f32x4*)(C + ro + bj * HALF + n * 16) = v; } }
    }
};
struct EpiFp8 {
    static constexpr bool PERM = true;
    unsigned char* O; int ldc; float scale;
    __device__ __forceinline__ void operator()(const Acc& acc, const Unit& u, int wr, int wc, int fr, int fq) const {
        const int row0 = u.pm * BM + wr * 64 + fr, col0 = u.pn * BM + wc * 32 + 8 * fq;
#pragma unroll
        for (int ai = 0; ai < 2; ++ai)
#pragma unroll
            for (int m = 0; m < 4; ++m) { unsigned char* rowp = O + (size_t)(row0 + ai * HALF + m * 16) * ldc + col0;
#pragma unroll
                for (int bj = 0; bj < 2; ++bj) { const f32x4 v0 = acc[ai][bj][m][0] * scale, v1 = acc[ai][bj][m][1] * scale; v2u w;
                    { unsigned t = 0u; t = __builtin_amdgcn_cvt_pk_fp8_f32(v0[0], v0[1], t, false); t = __builtin_amdgcn_cvt_pk_fp8_f32(v0[2], v0[3], t, true); w.x = t; t = 0u; t = __builtin_amdgcn_cvt_pk_fp8_f32(v1[0], v1[1], t, false); t = __builtin_amdgcn_cvt_pk_fp8_f32(v1[2], v1[3], t, true); w.y = t; }
                    *(v2u*)(rowp + bj * HALF) = w; } }
    }
};
struct EpiBf16Res {
    static constexpr bool PERM = true;
    bf16* O; int ldc; const float* resf; const bf16* resb; float rs; float ascale;
    __device__ __forceinline__ void operator()(const Acc& acc, const Unit& u, int wr, int wc, int fr, int fq) const {
        const int row0 = u.pm * BM + wr * 64 + fr, col0 = u.pn * BM + wc * 32 + 8 * fq;
#pragma unroll
        for (int ai = 0; ai < 2; ++ai)
#pragma unroll
            for (int m = 0; m < 4; ++m) { const size_t ro = (size_t)(row0 + ai * HALF + m * 16) * ldc + col0;
#pragma unroll
                for (int bj = 0; bj < 2; ++bj) { f32x4 r0, r1;
                    if (resf) { r0 = *(const f32x4*)(resf + ro + bj * HALF); r1 = *(const f32x4*)(resf + ro + bj * HALF + 4); }
                    else { const v4u w = *(const v4u*)(resb + ro + bj * HALF); r0 = (f32x4){__uint_as_float(w.x << 16), __uint_as_float(w.x & 0xffff0000u), __uint_as_float(w.y << 16), __uint_as_float(w.y & 0xffff0000u)};
                        r1 = (f32x4){__uint_as_float(w.z << 16), __uint_as_float(w.z & 0xffff0000u), __uint_as_float(w.w << 16), __uint_as_float(w.w & 0xffff0000u)}; }
                    const f32x4 v0 = acc[ai][bj][m][0] * ascale + rs * r0, v1 = acc[ai][bj][m][1] * ascale + rs * r1;
                    v4u w; w.x = cvt_pk_bf16(v0[0], v0[1]); w.y = cvt_pk_bf16(v0[2], v0[3]); w.z = cvt_pk_bf16(v1[0], v1[1]); w.w = cvt_pk_bf16(v1[2], v1[3]);
                    *(v4u*)(O + ro + bj * HALF) = w; } }
    }
};
struct EpiPre1 {
    static constexpr bool PERM = true;
    bf16* O; unsigned char* O8; int ldc; const float* resf; float rs; float* stats;
    __device__ __forceinline__ void operator()(const Acc& acc, const Unit& u, int wr, int wc, int fr, int fq) const {
        const int row0 = u.pm * BM + wr * 64 + fr, col0 = u.pn * BM + wc * 32 + 8 * fq;
#pragma unroll
        for (int ai = 0; ai < 2; ++ai)
#pragma unroll
            for (int m = 0; m < 4; ++m) { const int row = row0 + ai * HALF + m * 16; const size_t ro = (size_t)row * ldc + col0; float s1 = 0.f, s2 = 0.f;
#pragma unroll
                for (int bj = 0; bj < 2; ++bj) { const f32x4 r0 = *(const f32x4*)(resf + ro + bj * HALF), r1 = *(const f32x4*)(resf + ro + bj * HALF + 4);
                    const f32x4 v0 = acc[ai][bj][m][0] + rs * r0, v1 = acc[ai][bj][m][1] + rs * r1;
                    s1 += ((v0[0] + v0[1]) + (v0[2] + v0[3])) + ((v1[0] + v1[1]) + (v1[2] + v1[3]));
                    s2 += ((v0[0] * v0[0] + v0[1] * v0[1]) + (v0[2] * v0[2] + v0[3] * v0[3])) + ((v1[0] * v1[0] + v1[1] * v1[1]) + (v1[2] * v1[2] + v1[3] * v1[3]));
                    v4u w; w.x = cvt_pk_bf16(v0[0], v0[1]); w.y = cvt_pk_bf16(v0[2], v0[3]); w.z = cvt_pk_bf16(v1[0], v1[1]); w.w = cvt_pk_bf16(v1[2], v1[3]);
                    *(v4u*)(O + ro + bj * HALF) = w;
                    v2u w8; { unsigned t = 0u; t = __builtin_amdgcn_cvt_pk_fp8_f32(v0[0], v0[1], t, false); t = __builtin_amdgcn_cvt_pk_fp8_f32(v0[2], v0[3], t, true); w8.x = t; t = 0u; t = __builtin_amdgcn_cvt_pk_fp8_f32(v1[0], v1[1], t, false); t = __builtin_amdgcn_cvt_pk_fp8_f32(v1[2], v1[3], t, true); w8.y = t; }
                    *(v2u*)(O8 + ro + bj * HALF) = w8; }
                s1 += __shfl_xor(s1, 16); s1 += __shfl_xor(s1, 32); s2 += __shfl_xor(s2, 16); s2 += __shfl_xor(s2, 32);
                if (fq == 0) *(f32x2*)(stats + ((size_t)row * 32 + u.pn * 4 + wc) * 2) = (f32x2){s1, s2}; }
    }
};
struct EpiQFold {
    static constexpr bool PERM = true;
    bf16* O; int ldc; const float* stats; const float* c1; const float* c2; float scale; float ascale;
    __device__ __forceinline__ void operator()(const Acc& acc, const Unit& u, int wr, int wc, int fr, int fq) const {
        const int row0 = u.pm * BM + wr * 64 + fr, col0 = u.pn * BM + wc * 32 + 8 * fq;
#pragma unroll
        for (int bj = 0; bj < 2; ++bj) {
            const f32x4 a10 = *(const f32x4*)(c1 + col0 + bj * HALF), a11 = *(const f32x4*)(c1 + col0 + bj * HALF + 4), a20 = *(const f32x4*)(c2 + col0 + bj * HALF), a21 = *(const f32x4*)(c2 + col0 + bj * HALF + 4);
#pragma unroll
            for (int ai = 0; ai < 2; ++ai)
#pragma unroll
                for (int m = 0; m < 4; ++m) { const int row = row0 + ai * HALF + m * 16; const f32x2 st = *(const f32x2*)(stats + 2 * (size_t)row); const float mu = st[0], rstd = st[1];
                    const f32x4 v0 = ((acc[ai][bj][m][0] * ascale - mu * a10) * rstd + a20) * scale, v1 = ((acc[ai][bj][m][1] * ascale - mu * a11) * rstd + a21) * scale;
                    v4u w; w.x = cvt_pk_bf16(v0[0], v0[1]); w.y = cvt_pk_bf16(v0[2], v0[3]); w.z = cvt_pk_bf16(v1[0], v1[1]); w.w = cvt_pk_bf16(v1[2], v1[3]);
                    *(v4u*)(O + (size_t)row * ldc + col0 + bj * HALF) = w; } }
    }
};
struct EpiXoFold {
    static constexpr bool PERM = true;
    bf16* O; int ldc; const bf16* pre; const float* stats; const float* g; const float* b; float rs; float ascale;
    __device__ __forceinline__ void operator()(const Acc& acc, const Unit& u, int wr, int wc, int fr, int fq) const {
        const int row0 = u.pm * BM + wr * 64 + fr, col0 = u.pn * BM + wc * 32 + 8 * fq;
#pragma unroll
        for (int bj = 0; bj < 2; ++bj) {
            const f32x4 g0 = *(const f32x4*)(g + col0 + bj * HALF), g1 = *(const f32x4*)(g + col0 + bj * HALF + 4), b0 = *(const f32x4*)(b + col0 + bj * HALF), b1 = *(const f32x4*)(b + col0 + bj * HALF + 4);
#pragma unroll
            for (int ai = 0; ai < 2; ++ai)
#pragma unroll
                for (int m = 0; m < 4; ++m) { const int row = row0 + ai * HALF + m * 16; const size_t ro = (size_t)row * ldc + col0 + bj * HALF; const f32x2 st = *(const f32x2*)(stats + 2 * (size_t)row); const float mu = st[0], rstd = st[1];
                    const v4u pw = *(const v4u*)(pre + ro);
                    const f32x4 p0 = (f32x4){__uint_as_float(pw.x << 16), __uint_as_float(pw.x & 0xffff0000u), __uint_as_float(pw.y << 16), __uint_as_float(pw.y & 0xffff0000u)};
                    const f32x4 p1 = (f32x4){__uint_as_float(pw.z << 16), __uint_as_float(pw.z & 0xffff0000u), __uint_as_float(pw.w << 16), __uint_as_float(pw.w & 0xffff0000u)};
                    const f32x4 h0 = (p0 - mu) * rstd * g0 + b0, h1_ = (p1 - mu) * rstd * g1 + b1;
                    const f32x4 v0 = acc[ai][bj][m][0] * ascale + rs * h0, v1 = acc[ai][bj][m][1] * ascale + rs * h1_;
                    v4u w; w.x = cvt_pk_bf16(v0[0], v0[1]); w.y = cvt_pk_bf16(v0[2], v0[3]); w.z = cvt_pk_bf16(v1[0], v1[1]); w.w = cvt_pk_bf16(v1[2], v1[3]);
                    *(v4u*)(O + ro) = w; } }
    }
};
struct EpiSoftmax {
    static constexpr bool PERM = true;
    bf16* P; int ldc; LAS float* red;
    __device__ __forceinline__ void operator()(Acc& acc, const Unit& u, int wr, int wc, int fr, int fq) const {
        LAS float* RM = red + wr * 512; LAS float* RS = red + 1024 + wr * 512;
#pragma unroll
        for (int ai = 0; ai < 2; ++ai)
#pragma unroll
            for (int m = 0; m < 4; ++m) { float mx = -3.0e38f;
#pragma unroll
                for (int bj = 0; bj < 2; ++bj)
#pragma unroll
                    for (int n = 0; n < 2; ++n) { const f32x4 v = acc[ai][bj][m][n]; mx = fmaxf(mx, fmaxf(fmaxf(v[0], v[1]), fmaxf(v[2], v[3]))); }
                mx = fmaxf(mx, __shfl_xor(mx, 16)); mx = fmaxf(mx, __shfl_xor(mx, 32));
                if (fq == 0) RM[(ai * 64 + m * 16 + fr) * 4 + wc] = mx; }
        asm volatile("s_waitcnt lgkmcnt(0)" ::: "memory"); __builtin_amdgcn_s_barrier(); asm volatile("" ::: "memory");
#pragma unroll
        for (int ai = 0; ai < 2; ++ai)
#pragma unroll
            for (int m = 0; m < 4; ++m) { const f32x4 pm = *(const LAS f32x4*)(RM + (ai * 64 + m * 16 + fr) * 4); const float mx = fmaxf(fmaxf(pm[0], pm[1]), fmaxf(pm[2], pm[3])); float sm = 0.f;
#pragma unroll
                for (int bj = 0; bj < 2; ++bj)
#pragma unroll
                    for (int n = 0; n < 2; ++n) { f32x4 v = acc[ai][bj][m][n]; v[0] = __expf(v[0] - mx); v[1] = __expf(v[1] - mx); v[2] = __expf(v[2] - mx); v[3] = __expf(v[3] - mx); acc[ai][bj][m][n] = v; sm += (v[0] + v[1]) + (v[2] + v[3]); }
                sm += __shfl_xor(sm, 16); sm += __shfl_xor(sm, 32);
                if (fq == 0) RS[(ai * 64 + m * 16 + fr) * 4 + wc] = sm; }
        asm volatile("s_waitcnt lgkmcnt(0)" ::: "memory"); __builtin_amdgcn_s_barrier(); asm volatile("" ::: "memory");
        const int row0 = u.pm * BM + wr * 64 + fr, col0 = u.pn * BM + wc * 32 + 8 * fq;
#pragma unroll
        for (int ai = 0; ai < 2; ++ai)
#pragma unroll
            for (int m = 0; m < 4; ++m) { const f32x4 ps = *(const LAS f32x4*)(RS + (ai * 64 + m * 16 + fr) * 4); const float inv = __builtin_amdgcn_rcpf((ps[0] + ps[1]) + (ps[2] + ps[3]));
                bf16* rowp = P + (size_t)(row0 + ai * HALF + m * 16) * ldc + col0;
#pragma unroll
                for (int bj = 0; bj < 2; ++bj) { const f32x4 v0 = acc[ai][bj][m][0] * inv, v1 = acc[ai][bj][m][1] * inv;
                    v4u w; w.x = cvt_pk_bf16(v0[0], v0[1]); w.y = cvt_pk_bf16(v0[2], v0[3]); w.z = cvt_pk_bf16(v1[0], v1[1]); w.w = cvt_pk_bf16(v1[2], v1[3]);
                    *(v4u*)(rowp + bj * HALF) = w; } }
        asm volatile("s_waitcnt lgkmcnt(0)" ::: "memory"); __builtin_amdgcn_s_barrier(); asm volatile("" ::: "memory");
    }
};
struct EpiSwiglu {
    static constexpr bool PERM = true;
    bf16* act; const float* bias; float ws;
    __device__ __forceinline__ void operator()(const Acc& acc, const Unit& u, int wr, int wc, int fr, int fq) const {
        const int row0 = u.pm * BM + wr * 64 + fr, cc = wc * 32 + 8 * fq; const float* bp = bias + (size_t)u.e * 4096 + u.pn * BM + cc;
        f32x4 bv[2][2];
#pragma unroll
        for (int bj = 0; bj < 2; ++bj)
#pragma unroll
            for (int n = 0; n < 2; ++n) bv[bj][n] = *(const f32x4*)(bp + bj * HALF + 4 * n);
#pragma unroll
        for (int ai = 0; ai < 2; ++ai)
#pragma unroll
            for (int m = 0; m < 4; ++m) { unsigned char* rowp = (unsigned char*)act + (size_t)(row0 + ai * HALF + m * 16) * D + u.pn * HALF + cc;
                float o[8];
#pragma unroll
                for (int n = 0; n < 2; ++n) { const f32x4 g = acc[ai][0][m][n] * ws + bv[0][n], l = acc[ai][1][m][n] * ws + bv[1][n];
#pragma unroll
                    for (int k = 0; k < 4; ++k) { const float gl = fminf(g[k], 7.0f), li = fminf(fmaxf(l[k], -7.0f), 7.0f); o[n * 4 + k] = gl * sigmoidf_(1.702f * gl) * (li + 1.0f); } }
                v2u w; { unsigned t = 0u; t = __builtin_amdgcn_cvt_pk_fp8_f32(o[0], o[1], t, false); t = __builtin_amdgcn_cvt_pk_fp8_f32(o[2], o[3], t, true); w.x = t; t = 0u; t = __builtin_amdgcn_cvt_pk_fp8_f32(o[4], o[5], t, false); t = __builtin_amdgcn_cvt_pk_fp8_f32(o[6], o[7], t, true); w.y = t; }
                *(v2u*)rowp = w; }
    }
};
struct EpiDown {
    static constexpr bool PERM = true;
    bf16* ybuf; const float* bias; const int* list; const float* gates; float ws; const LAS int* tA; const LAS float* tG;
    __device__ __forceinline__ void operator()(const Acc& acc, const Unit& u, int wr, int wc, int fr, int fq) const {
        const int r0 = wr * 64 + fr, col0 = u.pn * BM + wc * 32 + 8 * fq; const float* bp = bias + (size_t)u.e * D + col0;
        f32x4 bv[2][2];
#pragma unroll
        for (int bj = 0; bj < 2; ++bj)
#pragma unroll
            for (int n = 0; n < 2; ++n) bv[bj][n] = *(const f32x4*)(bp + bj * HALF + 4 * n);
#pragma unroll
        for (int ai = 0; ai < 2; ++ai)
#pragma unroll
            for (int m = 0; m < 4; ++m) { const int r = r0 + ai * HALF + m * 16;
                int a; float g;
                if (tA) { a = tA[u.idx * 256 + r]; g = tG[u.idx * 256 + r]; } else if (r < u.rows) { a = list[u.e * MOE_CAP + u.mt * 256 + r]; g = gates[a]; } else { a = -1; g = 0.f; }
                if (a >= 0) { unsigned char* rowp = (unsigned char*)ybuf + (size_t)a * D + col0; const float g16 = g * 16.0f;
#pragma unroll
                    for (int bj = 0; bj < 2; ++bj) { const f32x4 v0 = (acc[ai][bj][m][0] * ws + bv[bj][0]) * g16, v1 = (acc[ai][bj][m][1] * ws + bv[bj][1]) * g16; v2u w;
                        { unsigned t = 0u; t = __builtin_amdgcn_cvt_pk_fp8_f32(v0[0], v0[1], t, false); t = __builtin_amdgcn_cvt_pk_fp8_f32(v0[2], v0[3], t, true); w.x = t; t = 0u; t = __builtin_amdgcn_cvt_pk_fp8_f32(v1[0], v1[1], t, false); t = __builtin_amdgcn_cvt_pk_fp8_f32(v1[2], v1[3], t, true); w.y = t; }
                        *(v2u*)(rowp + bj * HALF) = w; } } }
    }
};
}

#define XB_TMO      128
#define XB_XCNT(j)  (256  + 64 * (j))
#define XB_XSUB(j)  (1280 + 64 * (j))
#define XB_XGEN(j)  (2304 + 64 * (j))
#define XB_TOP      3328
#define XB_TOPGEN   3392
#define XCD_BAR_WORDS 3456
#define XB_SPIN_CAP (1u << 20)
__device__ __forceinline__ unsigned xb_ld(unsigned* p)              { return __hip_atomic_load(p, __ATOMIC_RELAXED, __HIP_MEMORY_SCOPE_AGENT); }
__device__ __forceinline__ unsigned xb_add(unsigned* p, unsigned v) { return __hip_atomic_fetch_add(p, v, __ATOMIC_RELAXED, __HIP_MEMORY_SCOPE_AGENT); }
__device__ __forceinline__ unsigned xb_xcc_id() { return (unsigned)__builtin_amdgcn_s_getreg((3 << 11) | 20) & 0xFu; }
#define XB_SPIN(cond, bar) do { unsigned _sp = 0; while (cond) { __builtin_amdgcn_s_sleep(1); \
    if ((++_sp & 255u) == 0u) { if (xb_ld(&(bar)[XB_TMO])) break; if (_sp > XB_SPIN_CAP) { atomicAdd(&(bar)[XB_TMO], 1u); break; } } } } while (0)
struct XcdBarrier { unsigned* bar; unsigned x; volatile LAS unsigned* st; };
__device__ __forceinline__ XcdBarrier xcd_barrier_post(unsigned* bar, volatile LAS unsigned* st) {
    XcdBarrier b; b.bar = bar; b.x = xb_xcc_id(); b.st = st;
    if (threadIdx.x == 0) (void)xb_add(&bar[XB_XCNT(b.x)], 1u);
    return b;
}
__device__ __forceinline__ void xcd_barrier_complete(unsigned* bar, unsigned x, unsigned& nloc, unsigned& nx) {
    const unsigned G = gridDim.x * gridDim.y * gridDim.z;
    unsigned sum, cnt, mine, sp = 0u;
    for (;;) {
        sum = 0u; cnt = 0u; mine = 0u;
#pragma unroll
        for (unsigned j = 0; j < 16; ++j) { const unsigned c = xb_ld(&bar[XB_XCNT(j)]); sum += c; cnt += (c > 0u) ? 1u : 0u; mine = (j == x) ? c : mine; }
        if (sum == G) break;
        __builtin_amdgcn_s_sleep(1);
        if ((++sp & 255u) == 0u) { if (xb_ld(&bar[XB_TMO])) break; if (sp > XB_SPIN_CAP) { atomicAdd(&bar[XB_TMO], 1u); break; } }
    }
    nloc = mine > 0u ? mine : 1u; nx = cnt > 0u ? cnt : 1u;
}
__device__ __forceinline__ void xcd_barrier(const XcdBarrier& b) {
    asm volatile("s_waitcnt vmcnt(0)" ::: "memory");
    __syncthreads();
    if (threadIdx.x == 0) {
        unsigned* bar = b.bar;
        __builtin_amdgcn_s_waitcnt(0);
        unsigned nloc = b.st[0], nx = b.st[1];
        if (nloc == 0u) { xcd_barrier_complete(bar, b.x, nloc, nx); b.st[0] = nloc; b.st[1] = nx; }
        const unsigned old = xb_add(&bar[XB_XSUB(b.x)], 1u);
        const unsigned gen = old / nloc;
        if (old + 1u == (gen + 1u) * nloc) {
            __builtin_amdgcn_fence(__ATOMIC_RELEASE, "agent");
            asm volatile("s_waitcnt vmcnt(0)" ::: "memory");
            const unsigned og = xb_add(&bar[XB_TOP], 1u);
            const unsigned tg = og / nx;
            if (og + 1u == (tg + 1u) * nx) xb_add(&bar[XB_TOPGEN], 1u);
            else XB_SPIN(xb_ld(&bar[XB_TOPGEN]) == tg, bar);
            __builtin_amdgcn_fence(__ATOMIC_ACQUIRE, "agent");
            xb_add(&bar[XB_XGEN(b.x)], 1u);
            asm volatile("s_waitcnt vmcnt(0)" ::: "memory");
        } else {
            XB_SPIN(xb_ld(&bar[XB_XGEN(b.x)]) == gen, bar);
            __builtin_amdgcn_fence(__ATOMIC_ACQUIRE, "agent");
            asm volatile("s_waitcnt vmcnt(0)" ::: "memory");
        }
    }
    __syncthreads();
}

__device__ __forceinline__ int tmap(int mode, int n) {
    if (mode == 0) return n;
    if (mode == 1) return n < GA1_COL ? n : (n < GA1_COL + 16 ? -1 : n - 16);
    const int j = n >> 1, par = n & 1; return 256 * (j >> 7) + 128 * par + (j & 127);
}
__device__ __forceinline__ void transpose_item(const float* W, int N, int Nout, int mode, bf16* WT, int item, int nnb, int lane) {
    const int nb = item % nnb, kbg = item / nnb, e = kbg >> 5, k0 = (kbg & 31) * 64, n0 = nb * 64;
    const int kq = lane & 7, nq = lane >> 3;
    const float* src = W + ((size_t)e * D + k0 + 8 * kq) * N + n0 + 4 * nq;
    f32x4 v[2][8]; bool inb[2];
#pragma unroll
    for (int g = 0; g < 2; ++g) { inb[g] = (n0 + 32 * g + 4 * nq) < N;
#pragma unroll
        for (int j = 0; j < 8; ++j) v[g][j] = inb[g] ? *(const f32x4*)(src + (size_t)j * N + 32 * g) : (f32x4){0.f, 0.f, 0.f, 0.f}; }
#pragma unroll
    for (int g = 0; g < 2; ++g)
#pragma unroll
        for (int c = 0; c < 4; ++c) { const int n = n0 + 32 * g + 4 * nq + c; const int dr = inb[g] ? tmap(mode, n) : -1;
            if (dr >= 0) { v4u w; w.x = pk2(v[g][0][c], v[g][1][c]); w.y = pk2(v[g][2][c], v[g][3][c]); w.z = pk2(v[g][4][c], v[g][5][c]); w.w = pk2(v[g][6][c], v[g][7][c]);
                *(v4u*)(WT + ((size_t)e * Nout + dr) * D + k0 + 8 * kq) = w; } }
}

__device__ __forceinline__ unsigned pk4_fp8(float a, float b, float c, float d) { unsigned w = 0u; w = __builtin_amdgcn_cvt_pk_fp8_f32(a, b, w, false); w = __builtin_amdgcn_cvt_pk_fp8_f32(c, d, w, true); return w; }
__device__ __forceinline__ void transpose_item_fp8(const float* W, int N, int Nout, int mode, unsigned char* WT, int item, int nnb, int lane, float scale, const float* rowscale = nullptr) {
    const int nb = item % nnb, kbg = item / nnb, e = kbg >> 4, k0 = (kbg & 15) * 128, n0 = nb * 32;
    const int kq = lane & 7, nq = lane >> 3;
    const int nv = n0 + 4 * nq; int ns = nv; if (mode == 3) { const int np = TILES_FP8[nv >> 8] * 256 + (nv & 255); ns = np < GA1_COL ? np : np + 16; }
    const float* src = W + ((size_t)e * D + k0 + 16 * kq) * N + ns;
    f32x4 v[16];
#pragma unroll
    for (int j = 0; j < 16; ++j) v[j] = __builtin_nontemporal_load((const f32x4*)(src + (size_t)j * N)) * (rowscale ? scale * rowscale[k0 + 16 * kq + j] : scale);
#pragma unroll
    for (int c = 0; c < 4; ++c) { const int dr = mode == 3 ? nv + c : tmap(mode, nv + c);
        v4u w; w.x = pk4_fp8(v[0][c], v[1][c], v[2][c], v[3][c]); w.y = pk4_fp8(v[4][c], v[5][c], v[6][c], v[7][c]); w.z = pk4_fp8(v[8][c], v[9][c], v[10][c], v[11][c]); w.w = pk4_fp8(v[12][c], v[13][c], v[14][c], v[15][c]);
        __builtin_nontemporal_store(w, (v4u*)(WT + ((size_t)e * Nout + dr) * D + k0 + 16 * kq)); }
}

__device__ __forceinline__ void ln1_finish(const float* stats, float* fst, int row) {
    const f32x4* p = (const f32x4*)(stats + (size_t)row * 64); float s1 = 0.f, s2 = 0.f;
#pragma unroll
    for (int i = 0; i < 16; ++i) { const f32x4 v = p[i]; s1 += v[0] + v[2]; s2 += v[1] + v[3]; }
    const float mu = s1 * (1.0f / D), rstd = __builtin_amdgcn_rsqf(s2 * (1.0f / D) - mu * mu + EPS);
    *(f32x2*)(fst + 2 * (size_t)row) = (f32x2){mu, rstd};
}
__device__ __forceinline__ void ln_apply(f32x4 (&v)[8], const float* g, const float* b, int lane) {
    float s = 0.f;
#pragma unroll
    for (int j = 0; j < 8; ++j) s += (v[j][0] + v[j][1]) + (v[j][2] + v[j][3]);
    const float mean = wave_sum(s) * (1.0f / D); float s2 = 0.f;
#pragma unroll
    for (int j = 0; j < 8; ++j) { v[j] = v[j] - mean; s2 += (v[j][0] * v[j][0] + v[j][1] * v[j][1]) + (v[j][2] * v[j][2] + v[j][3] * v[j][3]); }
    const float rstd = __builtin_amdgcn_rsqf(wave_sum(s2) * (1.0f / D) + EPS);
#pragma unroll
    for (int j = 0; j < 8; ++j) { const f32x4 gg = *(const f32x4*)(g + 4 * lane + 256 * j), bb = *(const f32x4*)(b + 4 * lane + 256 * j); v[j] = v[j] * rstd * gg + bb; }
}
#define COLB(j) (8 * lane + 512 * ((j) >> 1) + 4 * ((j) & 1))
__device__ __forceinline__ void ln_apply_b(f32x4 (&v)[8], const float* g, const float* b, int lane) {
    float s = 0.f;
#pragma unroll
    for (int j = 0; j < 8; ++j) s += (v[j][0] + v[j][1]) + (v[j][2] + v[j][3]);
    const float mean = wave_sum(s) * (1.0f / D); float s2 = 0.f;
#pragma unroll
    for (int j = 0; j < 8; ++j) { v[j] = v[j] - mean; s2 += (v[j][0] * v[j][0] + v[j][1] * v[j][1]) + (v[j][2] * v[j][2] + v[j][3] * v[j][3]); }
    const float rstd = __builtin_amdgcn_rsqf(wave_sum(s2) * (1.0f / D) + EPS);
#pragma unroll
    for (int j = 0; j < 8; ++j) { const f32x4 gg = *(const f32x4*)(g + COLB(j)), bb = *(const f32x4*)(b + COLB(j)); v[j] = v[j] * rstd * gg + bb; }
}
__device__ __forceinline__ void ln_apply_b_st(f32x4 (&v)[8], const float* g, const float* b, int lane, float& mean_o, float& rstd_o) {
    float s = 0.f;
#pragma unroll
    for (int j = 0; j < 8; ++j) s += (v[j][0] + v[j][1]) + (v[j][2] + v[j][3]);
    const float mean = wave_sum(s) * (1.0f / D); float s2 = 0.f;
#pragma unroll
    for (int j = 0; j < 8; ++j) { v[j] = v[j] - mean; s2 += (v[j][0] * v[j][0] + v[j][1] * v[j][1]) + (v[j][2] * v[j][2] + v[j][3] * v[j][3]); }
    const float rstd = __builtin_amdgcn_rsqf(wave_sum(s2) * (1.0f / D) + EPS);
#pragma unroll
    for (int j = 0; j < 8; ++j) { const f32x4 gg = *(const f32x4*)(g + COLB(j)), bb = *(const f32x4*)(b + COLB(j)); v[j] = v[j] * rstd * gg + bb; }
    mean_o = mean; rstd_o = rstd;
}
__device__ __forceinline__ void bf16x8_to_f32(const v4u w, f32x4& a, f32x4& b) {
    a = (f32x4){__uint_as_float(w.x << 16), __uint_as_float(w.x & 0xffff0000u), __uint_as_float(w.y << 16), __uint_as_float(w.y & 0xffff0000u)};
    b = (f32x4){__uint_as_float(w.z << 16), __uint_as_float(w.z & 0xffff0000u), __uint_as_float(w.w << 16), __uint_as_float(w.w & 0xffff0000u)}; }
__device__ __forceinline__ void row_load_bf16_b(const bf16* p, f32x4 (&v)[8], int lane) {
#pragma unroll
    for (int j2 = 0; j2 < 4; ++j2) bf16x8_to_f32(*(const v4u*)(p + 8 * lane + 512 * j2), v[2 * j2], v[2 * j2 + 1]);
}
__device__ __forceinline__ void row_store_bf16_b(bf16* o, const f32x4 (&v)[8], int lane) {
#pragma unroll
    for (int j2 = 0; j2 < 4; ++j2) { v4u w; w.x = pk2(v[2 * j2][0], v[2 * j2][1]); w.y = pk2(v[2 * j2][2], v[2 * j2][3]); w.z = pk2(v[2 * j2 + 1][0], v[2 * j2 + 1][1]); w.w = pk2(v[2 * j2 + 1][2], v[2 * j2 + 1][3]); *(v4u*)(o + 8 * lane + 512 * j2) = w; }
}
__device__ __forceinline__ void row_store_f32_b(float* o, const f32x4 (&v)[8], int lane) {
#pragma unroll
    for (int j = 0; j < 8; ++j) *(f32x4*)(o + COLB(j)) = v[j];
}
__device__ __forceinline__ void row_store_f32(float* o, const f32x4 (&v)[8], int lane) {
#pragma unroll
    for (int j = 0; j < 8; ++j) *(f32x4*)(o + 4 * lane + 256 * j) = v[j];
}
__device__ __forceinline__ void row_store_bf16(bf16* o, const f32x4 (&v)[8], int lane) {
#pragma unroll
    for (int j = 0; j < 8; ++j) { v2u w; w.x = pk2(v[j][0], v[j][1]); w.y = pk2(v[j][2], v[j][3]); *(v2u*)(o + 4 * lane + 256 * j) = w; }
}
__device__ __forceinline__ f32x4 ld_bf16x4(const bf16* p) { const v2u w = *(const v2u*)p; return (f32x4){bf2f(w.x & 0xffffu), bf2f(w.x >> 16), bf2f(w.y & 0xffffu), bf2f(w.y >> 16)}; }


typedef float f32x16 __attribute__((ext_vector_type(16)));
typedef short s16x4_t __attribute__((ext_vector_type(4)));
typedef __bf16 bf16x2_t __attribute__((ext_vector_type(2)));
__device__ __forceinline__ unsigned cvtpk(float lo, float hi) { f32x2 v = {lo, hi}; bf16x2_t b = __builtin_convertvector(v, bf16x2_t); return __builtin_bit_cast(unsigned, b); }
__device__ __forceinline__ int crow(int reg, int hh) { return (reg & 3) + 8 * (reg >> 2) + 4 * hh; }
__device__ __forceinline__ v4u piece16(const float (&v)[16], int hh2) {
    v4u w; if (hh2 == 0) { w.x = cvtpk(v[0], v[1]); w.y = cvtpk(v[2], v[3]); w.z = cvtpk(v[8], v[9]); w.w = cvtpk(v[10], v[11]); }
    else { w.x = cvtpk(v[4], v[5]); w.y = cvtpk(v[6], v[7]); w.z = cvtpk(v[12], v[13]); w.w = cvtpk(v[14], v[15]); }
    return w; }
constexpr int PP_GS = 0, PP_KS = 33792, PP_QI = 67584, PP_KH = 83968, PP_KI = 100352, PP_SEG = 116736, PP_GT = PP_SEG + 2048;

struct PrepIn { unsigned short kin[16]; v4u q0, q1; };
template <int KIND>
__device__ __forceinline__ void prep_load(PrepIn& R, int tid, int wave, const bf16* proj_, int b, int h, int c, int sl) {
    constexpr int DK = KIND == 0 ? 256 : 128; constexpr int QCOL = KIND == 0 ? GQ : HQ, KCOL = KIND == 0 ? GK : HF;
    const size_t tok0 = (size_t)b * SEQ + (size_t)c * 64; const int d = tid & 127, seg = wave >> 1, d0 = 128 * sl;
#pragma unroll
    for (int t = 0; t < 16; ++t) R.kin[t] = proj_[(tok0 + seg * 16 + t) * NPROJ + KCOL + h * DK + d0 + d];
    const bf16* qp = proj_ + (tok0 + (tid >> 3)) * NPROJ + QCOL + h * DK + d0 + 16 * (tid & 7);
    R.q0 = *(const v4u*)qp; R.q1 = *(const v4u*)(qp + 8);
}
template <int KIND>
__device__ __forceinline__ void prep_unit(LAS unsigned char* lds, int tid, int b, int h, int c, int nb_, int nh_, int nc_, bool has_next, PrepIn& cur, const bf16* proj_, const float* ga1_, const float* w_a2_, const float* b_a_, const float* lbt_,
                                          unsigned char* QF, unsigned char* KF, unsigned char* PF, float* LAM, unsigned char* VF) {
    constexpr int DK = KIND == 0 ? 256 : 128, DV = KIND == 0 ? 512 : 128, NSLAB = DK / 128, NEB = DV / 128;
    constexpr int QCOL = KIND == 0 ? GQ : HQ, KCOL = KIND == 0 ? GK : HF, VCOL = KIND == 0 ? GV : HI;
    const int lane = tid & 63, wave = __builtin_amdgcn_readfirstlane(tid >> 6), r = lane & 31, hh = lane >> 5;
    const size_t tok0 = (size_t)b * SEQ + (size_t)c * 64;
    LAS float* Gs = (LAS float*)(lds + PP_GS); LAS float* Ks = (LAS float*)(lds + PP_KS); LAS float* SEGT = (LAS float*)(lds + PP_SEG); LAS float* GT = (LAS float*)(lds + PP_GT);
    LAS unsigned char* QI = lds + PP_QI; LAS unsigned char* KH = lds + PP_KH; LAS unsigned char* KI = lds + PP_KI;
    f32x16 pacc;
#pragma unroll
    for (int i = 0; i < 16; ++i) pacc[i] = 0.f;
#pragma unroll
    for (int sl = 0; sl < NSLAB; ++sl) {
        const int d0 = 128 * sl;
        PrepIn nxt = cur;
        if (sl + 1 < NSLAB) prep_load<KIND>(nxt, tid, wave, proj_, b, h, c, sl + 1);
        else if (has_next) prep_load<KIND>(nxt, tid, wave, proj_, nb_, nh_, nc_, 0);
        const v4u q0 = cur.q0, q1 = cur.q1;
        {
            const int d = tid & 127, seg = wave >> 1;
            float w2[16]; float bb = 0.f, lb = 0.f;
            if constexpr (KIND == 0) {
#pragma unroll
                for (int q = 0; q < 16; ++q) w2[q] = w_a2_[q * 1024 + h * 256 + d0 + d];
                bb = b_a_[h * 256 + d0 + d];
            } else { lb = lbt_[h * 128 + d]; }
            float run = 0.f;
#pragma unroll
            for (int t = 0; t < 16; ++t) { const int i = seg * 16 + t; const size_t row = tok0 + i; float g, kv;
                if constexpr (KIND == 0) { float z = bb; const float* ga = ga1_ + row * 16;
#pragma unroll
                    for (int q = 0; q < 16; ++q) z += ga[q] * w2[q];
                    g = (fminf(z, 0.f) - __logf(1.0f + __expf(-fabsf(z)))) * 0.0625f; kv = bf2f(cur.kin[t]); }
                else { const float hf = bf2f(cur.kin[t]); const float f = lb + (1.0f - lb) * sigmoidf_(hf); g = __logf(f); kv = 1.0f - f; }
                run += g; Gs[i * 132 + d] = run; Ks[i * 132 + d] = kv; }
            SEGT[seg * 128 + d] = run;
        }
        __syncthreads();
        {   const int d = tid & 127, seg = wave >> 1; const float t0 = SEGT[d], t1 = SEGT[128 + d], t2 = SEGT[256 + d], t3 = SEGT[384 + d];
            const float off = seg == 0 ? 0.f : (seg == 1 ? t0 : (seg == 2 ? t0 + t1 : (t0 + t1) + t2));
            if (seg > 0) {
#pragma unroll
                for (int t = 0; t < 16; ++t) Gs[(seg * 16 + t) * 132 + d] += off; }
            if (seg == 3) { const float gt = off + t3; GT[d] = gt; LAM[d0 + d] = __expf(gt); }
        }
        __syncthreads();
        {
            const int ks = tid & 7, i = tid >> 3;
            float qv[16];
            qv[0] = bf2f(q0.x & 0xffffu); qv[1] = bf2f(q0.x >> 16); qv[2] = bf2f(q0.y & 0xffffu); qv[3] = bf2f(q0.y >> 16); qv[4] = bf2f(q0.z & 0xffffu); qv[5] = bf2f(q0.z >> 16); qv[6] = bf2f(q0.w & 0xffffu); qv[7] = bf2f(q0.w >> 16);
            qv[8] = bf2f(q1.x & 0xffffu); qv[9] = bf2f(q1.x >> 16); qv[10] = bf2f(q1.y & 0xffffu); qv[11] = bf2f(q1.y >> 16); qv[12] = bf2f(q1.z & 0xffffu); qv[13] = bf2f(q1.z >> 16); qv[14] = bf2f(q1.w & 0xffffu); qv[15] = bf2f(q1.w >> 16);
            float qt[16], kh[16], qp_[16];
#pragma unroll
            for (int q4 = 0; q4 < 4; ++q4) { const f32x4 g4 = *(const LAS f32x4*)(Gs + i * 132 + 16 * ks + 4 * q4), k4 = *(const LAS f32x4*)(Ks + i * 132 + 16 * ks + 4 * q4), t4 = *(const LAS f32x4*)(GT + 16 * ks + 4 * q4);
#pragma unroll
                for (int p = 0; p < 4; ++p) { const int dd = 4 * q4 + p; const float qq = KIND == 0 ? qv[dd] * 0.0625f : qv[dd] * sigmoidf_(qv[dd]);
                    qt[dd] = qq * __expf(g4[p]); qp_[dd] = qq * __expf(g4[p] - t4[p]); kh[dd] = k4[p] * __expf(-g4[p]); } }
#pragma unroll
            for (int h2 = 0; h2 < 2; ++h2) { const int slot = ((2 * ks + h2) ^ i) & 15;
                *(LAS v4u*)(QI + i * 256 + slot * 16) = piece16(qt, h2); *(LAS v4u*)(KH + i * 256 + slot * 16) = piece16(kh, h2);
                *(v4u*)(QF + (size_t)i * (DK * 2) + sl * 256 + slot * 16) = piece16(qp_, h2); }
        }
        __syncthreads();
        if (wave < 3) {
            const int jt = wave == 2 ? 1 : 0, it = wave == 0 ? 0 : 1, j = 32 * jt + r, i = 32 * it + r;
#pragma unroll
            for (int ks = 0; ks < 8; ++ks) { const bf16x8 a = *(const LAS bf16x8*)(KH + j * 256 + (((2 * ks + hh) ^ j) & 15) * 16), bq = *(const LAS bf16x8*)(QI + i * 256 + (((2 * ks + hh) ^ i) & 15) * 16);
                pacc = __builtin_amdgcn_mfma_f32_32x32x16_bf16(a, bq, pacc, 0, 0, 0); }
        }
        {
            const int d = tid & 127, s4 = tid >> 7; const float gt = GT[d]; float kt[16];
#pragma unroll
            for (int t = 0; t < 16; ++t) { const int j = 16 * s4 + t; kt[t] = Ks[j * 132 + d] * __expf(gt - Gs[j * 132 + d]); }
#pragma unroll
            for (int h2 = 0; h2 < 2; ++h2) *(LAS v4u*)(KI + d * 128 + (((2 * s4 + h2) ^ (d >> 1)) & 7) * 16) = piece16(kt, h2);
        }
        __syncthreads();
#pragma unroll
        for (int q = 0; q < 2; ++q) { const int pc = tid + 512 * q; *(v4u*)(KF + (size_t)d0 * 128 + pc * 16) = *(const LAS v4u*)(KI + pc * 16); }
        __syncthreads();
        cur = nxt;
    }
    if (wave < 3) {
        if (wave != 1) {
#pragma unroll
            for (int q = 0; q < 16; ++q) if (crow(q, hh) > r) pacc[q] = 0.f; }
#pragma unroll
        for (int s2 = 0; s2 < 2; ++s2) { v4u w; w.x = cvtpk(pacc[8 * s2 + 0], pacc[8 * s2 + 1]); w.y = cvtpk(pacc[8 * s2 + 2], pacc[8 * s2 + 3]); w.z = cvtpk(pacc[8 * s2 + 4], pacc[8 * s2 + 5]); w.w = cvtpk(pacc[8 * s2 + 6], pacc[8 * s2 + 7]);
            *(v4u*)(PF + (2 * wave + s2) * 1024 + lane * 16) = w; }
    }
}

__device__ __forceinline__ const bf16* vblock_src(int u, const bf16* proj_) {
    if (u < 4096) { const int pc = u >> 2, eb = u & 3, pair = pc >> 7, c = pc & 127; return proj_ + ((size_t)(pair >> 2) * SEQ + (size_t)c * 64) * NPROJ + GV + (pair & 3) * 512 + eb * 128; }
    const int pc = u - 4096, pair = pc >> 7, c = pc & 127; return proj_ + ((size_t)(pair >> 4) * SEQ + (size_t)c * 64) * NPROJ + HI + (pair & 15) * 128;
}
__device__ __forceinline__ void vblock_load(v2u (&vin)[4], const bf16* src, int tid) {
#pragma unroll
    for (int q = 0; q < 4; ++q) vin[q] = *(const v2u*)(src + (size_t)((tid >> 5) + 16 * q) * NPROJ + (tid & 31) * 4);
}
__device__ __forceinline__ void vblock_run(LAS unsigned char* lds, int tid, const v2u (&vin)[4], unsigned char* dst) {
    LAS float* Ks = (LAS float*)(lds + PP_KS); LAS unsigned char* KI = lds + PP_KI;
#pragma unroll
    for (int q = 0; q < 4; ++q) { const int j = (tid >> 5) + 16 * q, e4 = (tid & 31) * 4; const v2u w = vin[q]; *(LAS f32x4*)(Ks + j * 132 + e4) = (f32x4){bf2f(w.x & 0xffffu), bf2f(w.x >> 16), bf2f(w.y & 0xffffu), bf2f(w.y >> 16)}; }
    __syncthreads();
    {   const int e = tid & 127, s4 = tid >> 7; float vv[16];
#pragma unroll
        for (int t = 0; t < 16; ++t) vv[t] = Ks[(16 * s4 + t) * 132 + e];
#pragma unroll
        for (int h2 = 0; h2 < 2; ++h2) *(LAS v4u*)(KI + e * 128 + (((2 * s4 + h2) ^ (e >> 1)) & 7) * 16) = piece16(vv, h2);
    }
    __syncthreads();
#pragma unroll
    for (int q = 0; q < 2; ++q) { const int pc = tid + 512 * q; *(v4u*)(dst + pc * 16) = *(const LAS v4u*)(KI + pc * 16); }
    __syncthreads();
}

__device__ __forceinline__ void lds_wait_ge(volatile LAS unsigned* p, unsigned want) { unsigned n = 0; while (*p < want) { __builtin_amdgcn_s_sleep(1); if (++n > (1u << 22)) break; } }
template <int KIND>
__device__ __forceinline__ void scan_item(LAS unsigned char* lds, volatile LAS unsigned* flg, int role, int lane, unsigned seq0, int pflags, const unsigned char* QF, const unsigned char* KF, const unsigned char* PF, const unsigned char* LAM, const unsigned char* VF, bf16* out) {
    constexpr int DK = KIND == 0 ? 256 : 128, DV = KIND == 0 ? 512 : 128, NDT = DK / 32, QB = 64 * DK * 2, KB = DK * 128, VB = DV * 128, NC = KIND == 0 ? 2 : 4;
    constexpr int SQ = 0, SK = QB, SP = QB + KB, SL = SP + 6144, SV = SL + 1024, STG = SV + NC * 4096;
    static_assert(2 * STG <= MISC_OFF, "scan stages fit under the LDS control words");
#define DMA1(gu, l) __builtin_amdgcn_global_load_lds((const unsigned*)((const unsigned char*)(gu) + (size_t)loff), (LAS unsigned*)(l), 16, 0, 0)
    if ((pflags & 32) && role >= NC) return;
    if (role == NC || role == NC + 2) {
        unsigned loff = (unsigned)lane * 16u; asm volatile("" : "+v"(loff));
        unsigned lvoff = (unsigned)(lane >> 2) * (unsigned)(NPROJ * 2) + (unsigned)(lane & 3) * 16u; asm volatile("" : "+v"(lvoff));
#pragma nounroll
        for (int c = 0; c < 128; ++c) { const unsigned seq = seq0 + c; const int st = seq & 1; LAS unsigned char* sb_ = lds + st * STG;
            if (st != ((role - NC) >> 1)) continue;
#pragma unroll
            for (int k = 0; k < NC; ++k) lds_wait_ge(flg + 4 + 4 * st + k, seq >> 1);
            asm volatile("" ::: "memory");
            const unsigned char* g_;
#pragma unroll
            for (int k = 0; k < NC; ++k)
#pragma unroll
                for (int q_ = 0; q_ < 4; ++q_) __builtin_amdgcn_global_load_lds((const unsigned*)(VF + ((size_t)c * 64 + 16 * q_) * (NPROJ * 2) + k * 64 + (size_t)lvoff), (LAS unsigned*)(sb_ + SV + k * 4096 + q_ * 1024), 16, 0, 0);
            g_ = PF + (size_t)c * 6144;
#pragma unroll
            for (int q_ = 0; q_ < 6; ++q_) DMA1(g_ + q_ * 1024, sb_ + SP + q_ * 1024);
            DMA1(LAM + (size_t)c * 1024, sb_ + SL);
            g_ = QF + (size_t)c * QB;
#pragma unroll
            for (int q_ = 0; q_ < QB / 1024; ++q_) DMA1(g_ + q_ * 1024, sb_ + SQ + q_ * 1024);
            VM_WAIT(); flg[st] = seq + 1u; }
        return;
    }
    if (role == NC + 1 || role == NC + 3) {
        unsigned loff = (unsigned)lane * 16u; asm volatile("" : "+v"(loff));
#pragma nounroll
        for (int c = 0; c < 128; ++c) { const unsigned seq = seq0 + c; const int st = seq & 1; LAS unsigned char* sb_ = lds + st * STG;
            if (st != ((role - NC) >> 1)) continue;
#pragma unroll
            for (int k = 0; k < NC; ++k) lds_wait_ge(flg + 12 + 4 * st + k, seq >> 1);
            asm volatile("" ::: "memory");
            const unsigned char* g_ = KF + (size_t)c * KB;
#pragma unroll
            for (int q_ = 0; q_ < KB / 1024; ++q_) DMA1(g_ + q_ * 1024, sb_ + SK + q_ * 1024);
            VM_WAIT(); flg[2 + st] = seq + 1u; }
        return;
    }
#undef DMA1
    if (role > NC + 3) return;
    const int r = lane & 31, hh = lane >> 5;
    bf16* outw = out + role * 32;
    f32x16 S[NDT];
#pragma unroll
    for (int dt = 0; dt < NDT; ++dt)
#pragma unroll
        for (int q = 0; q < 16; ++q) S[dt][q] = 0.f;
#pragma nounroll
    for (int c = 0; c < 128; ++c) {
        const unsigned seq = seq0 + c; const int st = seq & 1;
        LAS unsigned char* base = lds + st * STG;
        if (!(pflags & 32)) lds_wait_ge(flg + st, seq + 1u);
        asm volatile("" ::: "memory");
        if (pflags & 16) { flg[4 + 4 * st + role] = (seq >> 1) + 1u; lds_wait_ge(flg + 2 + st, seq + 1u); flg[12 + 4 * st + role] = (seq >> 1) + 1u; continue; }
#define DSR(dst, addr) asm volatile("ds_read_b128 %0, %1" : "=v"(dst) : "v"(addr) : "memory")
#define LGK(n) do { asm volatile("s_waitcnt lgkmcnt(" #n ")" ::: "memory"); __builtin_amdgcn_sched_barrier(0); } while (0)
        constexpr int NKS = DK / 16;
        unsigned sbase = (unsigned)(size_t)base; asm volatile("" : "+v"(sbase));
        const unsigned aV = sbase + SV + role * 4096 + (4 * hh + ((lane & 15) >> 2)) * 64 + (16 * ((lane >> 4) & 1) + 4 * (lane & 3)) * 2, aP = sbase + SP + lane * 16;
        const unsigned aQ0 = (sbase + SQ + r * (DK * 2)) | ((((r >> 1) & 7) << 5) | (((r & 1) ^ hh) << 4));
        const unsigned aK = sbase + SK + r * 128, aL = sbase + SL + hh * 16;
        const unsigned swz = ((r >> 1) & 7) << 4;
        s16x4_t vt[4][2];
#define VFR(s_) __builtin_shufflevector(vt[s_][0], vt[s_][1], 0, 1, 2, 3, 4, 5, 6, 7)
        {
            f32x4 lm[2][4];
#pragma unroll
            for (int s_ = 0; s_ < 4; ++s_) DSR(lm[0][s_], aL + (unsigned)((8 * s_) * 4));
#pragma unroll
            for (int dt = 0; dt < NDT; ++dt) {
                __builtin_amdgcn_sched_barrier(0);
                if (dt + 1 < NDT) {
#pragma unroll
                    for (int s_ = 0; s_ < 4; ++s_) DSR(lm[(dt + 1) & 1][s_], aL + (unsigned)((32 * (dt + 1) + 8 * s_) * 4));
                    LGK(4); } else { LGK(0); }
#pragma unroll
                for (int g = 0; g < 4; ++g)
#pragma unroll
                    for (int p = 0; p < 4; ++p) S[dt][4 * g + p] *= lm[dt & 1][g][p];
                __builtin_amdgcn_sched_barrier(0);
            }
        }
        f32x16 O[2];
#pragma unroll
        for (int it = 0; it < 2; ++it)
#pragma unroll
            for (int q = 0; q < 16; ++q) O[it][q] = 0.f;
        bf16x8 qf[2][2], pf[6];
#define SCAN_LOADQ(buf, ks) do { const unsigned a_ = (aQ0 ^ (unsigned)((((ks) & 7) << 5))) + (unsigned)((((ks) >> 3) << 8)); DSR(qf[buf][0], a_); DSR(qf[buf][1], a_ + 32u * (DK * 2)); } while (0)
        SCAN_LOADQ(0, 0);
#pragma unroll
        for (int ks = 0; ks < NKS; ++ks) {
            __builtin_amdgcn_sched_barrier(0);
            if (ks + 1 < NKS) { SCAN_LOADQ((ks + 1) & 1, ks + 1); LGK(2); }
            else {
#pragma unroll
                for (int f = 0; f < 4; ++f) DSR(pf[f], aP + f * 1024);
#pragma unroll
                for (int s_ = 0; s_ < 4; ++s_) {
                    asm volatile("ds_read_b64_tr_b16 %0, %1" : "=v"(vt[s_][0]) : "v"(aV + (unsigned)((16 * s_) * 64)) : "memory");
                    asm volatile("ds_read_b64_tr_b16 %0, %1" : "=v"(vt[s_][1]) : "v"(aV + (unsigned)((16 * s_ + 8) * 64)) : "memory"); }
                LGK(12); }
            const int dt = ks >> 1, s2 = ks & 1;
            v4u sw; sw.x = cvtpk(S[dt][8 * s2 + 0], S[dt][8 * s2 + 1]); sw.y = cvtpk(S[dt][8 * s2 + 2], S[dt][8 * s2 + 3]); sw.z = cvtpk(S[dt][8 * s2 + 4], S[dt][8 * s2 + 5]); sw.w = cvtpk(S[dt][8 * s2 + 6], S[dt][8 * s2 + 7]);
            const bf16x8 sb = __builtin_bit_cast(bf16x8, sw);
            O[0] = __builtin_amdgcn_mfma_f32_32x32x16_bf16(sb, qf[ks & 1][0], O[0], 0, 0, 0);
            O[1] = __builtin_amdgcn_mfma_f32_32x32x16_bf16(sb, qf[ks & 1][1], O[1], 0, 0, 0);
            __builtin_amdgcn_sched_barrier(0);
        }
#undef SCAN_LOADQ
        __builtin_amdgcn_sched_barrier(0);
        DSR(pf[4], aP + 4 * 1024); DSR(pf[5], aP + 5 * 1024);
        LGK(2);

#pragma unroll
        for (int s = 0; s < 2; ++s) O[0] = __builtin_amdgcn_mfma_f32_32x32x16_bf16(VFR(s), pf[s], O[0], 0, 0, 0);
#pragma unroll
        for (int s = 0; s < 2; ++s) O[1] = __builtin_amdgcn_mfma_f32_32x32x16_bf16(VFR(s), pf[2 + s], O[1], 0, 0, 0);
        __builtin_amdgcn_sched_barrier(0);
        LGK(0);
#pragma unroll
        for (int s = 2; s < 4; ++s) O[1] = __builtin_amdgcn_mfma_f32_32x32x16_bf16(VFR(s), pf[2 + s], O[1], 0, 0, 0);
        __builtin_amdgcn_sched_barrier(0);
        flg[4 + 4 * st + role] = (seq >> 1) + 1u;
        if (!(pflags & 8)) {   const bf16* opu = outw + (size_t)c * 64 * D;
            unsigned lo = (unsigned)(r * D + 4 * hh) * 2u; asm volatile("" : "+v"(lo));
#pragma unroll
            for (int it = 0; it < 2; ++it)
#pragma unroll
                for (int g = 0; g < 4; ++g) { v2u w; w.x = cvtpk(O[it][4 * g + 0], O[it][4 * g + 1]); w.y = cvtpk(O[it][4 * g + 2], O[it][4 * g + 3]);
                    *(v2u*)((unsigned char*)(opu + (size_t)(32 * it) * D + 8 * g) + (size_t)lo) = w; } }
        if (!(pflags & 32)) lds_wait_ge(flg + 2 + st, seq + 1u);
        asm volatile("" ::: "memory");
        __builtin_amdgcn_sched_barrier(0);
        {
            constexpr int NF = 4 * NDT;
            bf16x8 ring[8];
#define SCAN_KADDR(j) (aK + (unsigned)(((j) % NDT) * 4096) + (unsigned)((((2 * ((j) / NDT) + hh) << 4) ^ swz) & 0x70))
#pragma unroll
            for (int j = 0; j < 8; ++j) DSR(ring[j], SCAN_KADDR(j));
#pragma unroll
            for (int j = 0; j < NF; ++j) {
                __builtin_amdgcn_sched_barrier(0);
                const int young = (NF - 1 - j) < 7 ? (NF - 1 - j) : 7;
                if (young == 7) LGK(7); else if (young == 6) LGK(6); else if (young == 5) LGK(5); else if (young == 4) LGK(4); else if (young == 3) LGK(3); else if (young == 2) LGK(2); else if (young == 1) LGK(1); else LGK(0);
                S[j % NDT] = __builtin_amdgcn_mfma_f32_32x32x16_bf16(ring[j & 7], VFR(j / NDT), S[j % NDT], 0, 0, 0);
                __builtin_amdgcn_sched_barrier(0);
                if (j + 8 < NF) DSR(ring[j & 7], SCAN_KADDR(j + 8));
            }
#undef SCAN_KADDR
        }
#undef DSR
#undef LGK
#undef VFR
        LDS_WAIT();
        flg[12 + 4 * st + role] = (seq >> 1) + 1u;
    }
}

struct Args { const float* in[25]; float* out; unsigned char* ws; int ph_lo, ph_hi, flags, pad; };
constexpr int N_PHASES = 17;

__global__ void __launch_bounds__(NTHREADS, 2) fwd_kernel(Args args) {
    extern __shared__ __attribute__((aligned(16))) unsigned char lds_raw[];
    LAS unsigned char* lds = (LAS unsigned char*)lds_raw;
    volatile LAS unsigned* MISC = (volatile LAS unsigned*)(lds + MISC_OFF);
    const int tid = threadIdx.x, lane = tid & 63, wave = __builtin_amdgcn_readfirstlane(tid >> 6);
    const int G = gridDim.x, bx = blockIdx.x;
    const int vcu = (G % 8 == 0) ? (bx % 8) * (G / 8) + bx / 8 : bx;
    const int gw = vcu * NWAVES + wave, NGW = G * NWAVES;
    unsigned* ctl = (unsigned*)(args.ws + WS_CTL);
#define x_in (args.in[0])
#define mem_in (args.in[1])
#define w_in (args.in[2])
#define b_in (args.in[3])
#define w_a2 (args.in[4])
#define b_a (args.in[5])
#define gla_g (args.in[6])
#define hgrn_g (args.in[7])
#define lb_logits (args.in[8])
#define w_mix_o (args.in[9])
#define w_xq (args.in[10])
#define w_mem_kv (args.in[11])
#define w_xo (args.in[12])
#define w_router (args.in[13])
#define b_router (args.in[14])
#define w_gate_up (args.in[15])
#define b_gate_up (args.in[16])
#define w_down (args.in[17])
#define b_down (args.in[18])
#define ln1_g (args.in[19])
#define ln1_b (args.in[20])
#define ln2_g (args.in[21])
#define ln2_b (args.in[22])
#define ln3_g (args.in[23])
#define ln3_b (args.in[24])
#define WSP(type, off) ((type*)(args.ws + (off)))
#define ws_ (args.ws)
#define Win_t WSP(bf16, WS_WIN_T)
#define Wo_t WSP(bf16, WS_WO_T)
#define Wxq_t WSP(bf16, WS_WXQ_T)
#define Wkv_t WSP(bf16, WS_WKV_T)
#define Wxo_t WSP(bf16, WS_WXO_T)
#define Wgu_t WSP(bf16, WS_WGU_T)
#define Wd_t WSP(bf16, WS_WD_T)
#define xb WSP(bf16, WS_XB)
#define memb WSP(bf16, WS_MEMB)
#define ga1 WSP(float, WS_GA1)
#define binc WSP(float, WS_BINC)
#define bgup WSP(float, WS_BGUP)
#define lbt WSP(float, WS_LB)
#define proj WSP(bf16, WS_PROJ)
#define glog WSP(float, WS_GLOG)
#define ogla WSP(float, WS_OGLA)
#define oh WSP(float, WS_OH)
#define merged WSP(bf16, WS_MERGED)
#define pre1 WSP(float, WS_PRE1)
#define h1 WSP(float, WS_H1)
#define h1b WSP(bf16, WS_H1B)
#define qb WSP(bf16, WS_Q)
#define kk WSP(bf16, WS_KK)
#define vt WSP(bf16, WS_VT)
#define sc WSP(float, WS_SC)
#define Pb WSP(bf16, WS_P)
#define ao WSP(bf16, WS_AO)
#define pre2 WSP(float, WS_PRE2)
#define h2 WSP(float, WS_H2)
#define h2b WSP(bf16, WS_H2B)
#define list WSP(int, WS_LIST)
#define gates WSP(float, WS_GATES)
#define act WSP(bf16, WS_ACT)
#define ybuf WSP(bf16, WS_YBUF)
#define ecnt (ctl + CW_CNT)

    for (int u = tid; u < (LDS_BYTES - MISC_OFF) / 4; u += NTHREADS) ((LAS unsigned*)(lds + MISC_OFF))[u] = 0u;
    __syncthreads();
    const int lo = args.ph_lo, hi = args.ph_hi;
    const bool multi = (hi - lo) > 1;
    XcdBarrier bar; bar.bar = ctl + CW_BAR; bar.x = 0; bar.st = nullptr;
    if (multi) bar = xcd_barrier_post(ctl + CW_BAR, MISC + 8);
#ifndef PHMASK
#define PHMASK 0x1FFFF
#endif
#define IN(k) (((PHMASK >> (k)) & 1) && lo <= (k) && (k) < hi)
#define SEAM(k) do { if (IN(k) && IN((k) + 1)) xcd_barrier(bar); } while (0)

    if (IN(0)) {
        {
            const int idx = bx * 512 + tid;
            if (idx < D * NE) { const float w = w_router[idx]; const unsigned h = pk2(w, 0.f) & 0xffffu; const float r = w - __uint_as_float(h << 16); const unsigned l = pk2(r, 0.f) & 0xffffu;
                const int k = idx >> 5, e = idx & 31; WSP(unsigned short, WS_WRH)[e * D + k] = (unsigned short)h; WSP(unsigned short, WS_WRL)[e * D + k] = (unsigned short)l; }
            if (G * 512 < D * NE) for (int i2 = idx + G * 512; i2 < D * NE; i2 += G * 512) { const float w = w_router[i2]; const unsigned h = pk2(w, 0.f) & 0xffffu; const float r = w - __uint_as_float(h << 16); const unsigned l = pk2(r, 0.f) & 0xffffu;
                const int k = i2 >> 5, e = i2 & 31; WSP(unsigned short, WS_WRH)[e * D + k] = (unsigned short)h; WSP(unsigned short, WS_WRL)[e * D + k] = (unsigned short)l; }
        }
        {
            const int nnb0 = (DIN + 63) / 64;
            for (int it = gw; it < nnb0 * 32; it += NGW) transpose_item(w_in, DIN, NPROJ, 1, Win_t, it, nnb0, lane);
            for (int it = gw; it < 64 * 32; it += NGW) transpose_item(w_mem_kv, 2 * D, 2 * D, 0, Wkv_t, it, 64, lane);
            for (int it = gw; it < N_FP8_TILES * 8 * 16; it += NGW) transpose_item_fp8(w_in, DIN, N_FP8_TILES * 256, 3, ws_ + WS_GLOG + 32 * MiB, it, N_FP8_TILES * 8, lane, 256.0f);
        }
        {   LAS float* W1t = (LAS float*)lds;
            for (int idx = tid; idx < D * 4; idx += NTHREADS) { const int c = idx >> 2, q4 = idx & 3; const f32x4 w4 = *(const f32x4*)(w_in + (size_t)c * DIN + GA1_COL + 4 * q4);
                W1t[(4 * q4 + 0) * D + c] = w4[0]; W1t[(4 * q4 + 1) * D + c] = w4[1]; W1t[(4 * q4 + 2) * D + c] = w4[2]; W1t[(4 * q4 + 3) * D + c] = w4[3]; }
            __syncthreads();
            f32x4 vn[8];
            if (gw < T) {
#pragma unroll
                for (int j = 0; j < 8; ++j) vn[j] = *(const f32x4*)(x_in + (size_t)gw * D + 4 * lane + 256 * j); }
            for (int row = gw; row < T; row += NGW) {
                f32x4 v[8];
#pragma unroll
                for (int j = 0; j < 8; ++j) v[j] = vn[j];
                if (row + NGW < T) {
#pragma unroll
                    for (int j = 0; j < 8; ++j) vn[j] = *(const f32x4*)(x_in + (size_t)(row + NGW) * D + 4 * lane + 256 * j); }
                row_store_bf16(xb + (size_t)row * D, v, lane);
#pragma unroll
                for (int j = 0; j < 8; ++j) *(unsigned*)(ws_ + WS_GLOG + (size_t)row * D + 4 * lane + 256 * j) = pk4_fp8(v[j][0], v[j][1], v[j][2], v[j][3]);
                float mine = 0.f;
#pragma unroll 2
                for (int r16 = 0; r16 < 16; ++r16) { float p = 0.f;
#pragma unroll
                    for (int j = 0; j < 8; ++j) { const f32x4 w4 = *(const LAS f32x4*)(W1t + r16 * D + 4 * lane + 256 * j); p += (v[j][0] * w4[0] + v[j][1] * w4[1]) + (v[j][2] * w4[2] + v[j][3] * w4[3]); }
                    const float sum = wave_sum(p); if (lane == r16) mine = sum; }
                if (lane < 16) ga1[(size_t)row * 16 + lane] = mine + b_in[GA1_COL + lane];
            }
        }
        for (int row = gw; row < NBATCH * NMEM; row += NGW) {
            f32x4 v[8];
#pragma unroll
            for (int j = 0; j < 8; ++j) v[j] = *(const f32x4*)(mem_in + (size_t)row * D + 4 * lane + 256 * j);
            row_store_bf16(memb + (size_t)row * D, v, lane);
        }
        for (int i = bx * NTHREADS + tid; i < NPROJ; i += G * NTHREADS) binc[i] = b_in[i < GA1_COL ? i : i + 16];
        for (int i = bx * NTHREADS + tid; i < NE * 4096; i += G * NTHREADS) { const int e = i >> 12, n = i & 4095; bgup[e * 4096 + tmap(2, n)] = b_gate_up[i]; }
        for (int i = bx * NTHREADS + tid; i < D; i += G * NTHREADS) { const float l0 = lb_logits[i], l1 = lb_logits[D + i]; const float m = fmaxf(l0, l1); const float e0 = __expf(l0 - m), e1 = __expf(l1 - m); lbt[i] = e0 / (e0 + e1); }
    }
    SEAM(0);
    if (IN(1)) {
        {
            pg8::SchedSel S{(const char*)xb, (const char*)Win_t, T / 256, N_BF16_TILES, G, bx, (size_t)256 * D * 2, (size_t)256 * D * 2, 0};
            pg8::EpiBf16G E{proj, NPROJ, binc, 1.0f, 1.0f};
            pg8::gemm_phase<pg8::EpiBf16G, pg8::SchedSel, false>(lds, D, D, D, S, E); }
        {
            pg8::SchedSel S{(const char*)(ws_ + WS_GLOG), (const char*)(ws_ + WS_GLOG + 32 * MiB), T / 256, N_FP8_TILES, G, bx, (size_t)256 * D, (size_t)256 * D, 1};
            pg8::EpiBf16G E{proj, NPROJ, binc, 1.0f, 1.0f / 256.0f};
            pg8::gemm_phase<pg8::EpiBf16G, pg8::SchedSel, false, 1>(lds, D, D, D, S, E); }
    }
    SEAM(1);
    if (IN(3)) {
        {
            pg8::SchedKV S{(const char*)memb, (const char*)Wkv_t, G, bx};
            pg8::EpiKV E{kk, vt};
            pg8::gemm_phase<pg8::EpiKV, pg8::SchedKV, false>(lds, D, D, D, S, E);
        }
        {   PrepIn cur;
            if (bx < 1024) prep_load<0>(cur, tid, wave, proj, (bx >> 7) >> 2, (bx >> 7) & 3, bx & 127, 0);
            for (int u = bx; u < 1024; u += G) { const int pair = u >> 7, c = u & 127; const size_t pc = (size_t)pair * 128 + c; const int un = u + G; const bool hn = un < 1024;
                prep_unit<0>(lds, tid, pair >> 2, pair & 3, c, (un >> 7) >> 2, (un >> 7) & 3, un & 127, hn, cur, proj, ga1, w_a2, b_a, lbt, ws_ + WS_QFG + pc * 32768, ws_ + WS_KFG + pc * 32768, ws_ + WS_PFG + pc * 6144, (float*)(ws_ + WS_LAMG + pc * 1024), ws_ + WS_VFG + pc * 65536); }
            unsigned* hq = ctl + CW_HQ;
            if (tid == 0) MISC[40] = __hip_atomic_fetch_add(hq, 1u, RLX_AGENT);
            __syncthreads();
            int u = (int)MISC[40];
            if (u < 4096) prep_load<1>(cur, tid, wave, proj, (u >> 7) >> 4, (u >> 7) & 15, u & 127, 0);
            while (u < 4096) {
                __syncthreads();
                if (tid == 0) MISC[40] = __hip_atomic_fetch_add(hq, 1u, RLX_AGENT);
                __syncthreads();
                const int un = (int)MISC[40]; const bool hn = un < 4096;
                const int pair = u >> 7, c = u & 127; const size_t pc = (size_t)pair * 128 + c;
                prep_unit<1>(lds, tid, pair >> 4, pair & 15, c, (un >> 7) >> 4, (un >> 7) & 15, un & 127, hn, cur, proj, ga1, w_a2, b_a, lbt, ws_ + WS_QFH + pc * 16384, ws_ + WS_KFH + pc * 16384, ws_ + WS_PFH + pc * 6144, (float*)(ws_ + WS_LAMH + pc * 1024), ws_ + WS_VFH + pc * 16384);
                u = un;
            }
        }
    }
    SEAM(3);
    if (IN(4)) {
        const int NSCAN = 96; const bool split = G >= 192;
        volatile LAS unsigned* flg = MISC + 16;
        if (!(args.flags & 2) && (!split || bx < NSCAN)) {
            unsigned seq0 = 0u;
            for (int it = bx; it < NSCAN; it += (split ? NSCAN : G), seq0 += 128u) {
                if (it < 64) { const int pair = it & 7, e2 = it >> 3;
                    scan_item<0>(lds, flg, wave, lane, seq0, args.flags, ws_ + WS_QFG + (size_t)pair * 128 * 32768, ws_ + WS_KFG + (size_t)pair * 128 * 32768, ws_ + WS_PFG + (size_t)pair * 128 * 6144, ws_ + WS_LAMG + (size_t)pair * 128 * 1024,
                                 (const unsigned char*)(proj + (size_t)(pair >> 2) * SEQ * NPROJ + GV + (pair & 3) * 512 + e2 * 64), (bf16*)ogla + (size_t)(pair >> 2) * SEQ * D + (pair & 3) * 512 + e2 * 64);
                } else { const int pair = it - 64;
                    scan_item<1>(lds, flg, wave, lane, seq0, args.flags, ws_ + WS_QFH + (size_t)pair * 128 * 16384, ws_ + WS_KFH + (size_t)pair * 128 * 16384, ws_ + WS_PFH + (size_t)pair * 128 * 6144, ws_ + WS_LAMH + (size_t)pair * 128 * 1024,
                                 (const unsigned char*)(proj + (size_t)(pair >> 4) * SEQ * NPROJ + HI + (pair & 15) * 128), (bf16*)oh + (size_t)(pair >> 4) * SEQ * D + (pair & 15) * 128);
                }
            }
        }
        if (!(args.flags & 1) && (!split || bx >= NSCAN)) {
            if (!split) __syncthreads();
            constexpr int CWAVES = 8;
            if (split && wave >= CWAVES) {   } else {
            const int cw = split ? (bx - NSCAN) * CWAVES + wave : gw, NCW = split ? (G - NSCAN) * CWAVES : NGW;
            for (int it = cw; it < 32 * 32; it += NCW) transpose_item(w_mix_o, D, D, 0, Wo_t, it, 32, lane);
            for (int it = cw; it < 64 * 16; it += NCW) transpose_item_fp8(w_xq, D, D, 0, (unsigned char*)Wxq_t, it, 64, lane, 256.0f, ln1_g);
            for (int it = cw; it < 64 * 16; it += NCW) transpose_item_fp8(w_xo, D, D, 0, (unsigned char*)Wxo_t, it, 64, lane, 256.0f);
            for (int it = cw; it < 128 * 16 * NE; it += NCW) transpose_item_fp8(w_gate_up, 2 * D, 2 * D, 2, (unsigned char*)Wgu_t, it, 128, lane, 256.0f);
            for (int it = cw; it < 64 * 16 * NE; it += NCW) transpose_item_fp8(w_down, D, D, 0, (unsigned char*)Wd_t, it, 64, lane, 256.0f);
            }
        }
    }
    SEAM(4);
    if (IN(5)) {
        if (bx < 64) {
            const int cq = tid & 7, ks = tid >> 3;
            const float* src = w_xq + (size_t)ks * D + bx * 32 + 4 * cq;
            f32x4 s1 = {0.f, 0.f, 0.f, 0.f}, s2 = {0.f, 0.f, 0.f, 0.f};
#pragma unroll 8
            for (int i = 0; i < 32; ++i) { const f32x4 w = *(const f32x4*)(src + (size_t)64 * i * D); s1 += ln1_g[ks + 64 * i] * w; s2 += ln1_b[ks + 64 * i] * w; }
            LAS f32x4* red = (LAS f32x4*)lds;
            red[(ks * 8 + cq) * 2] = s1; red[(ks * 8 + cq) * 2 + 1] = s2;
            __syncthreads();
            if (tid < 64) { const int which = tid >> 5, col = tid & 31; float a = 0.f;
                for (int k2 = 0; k2 < 64; ++k2) a += ((LAS float*)lds)[((k2 * 8 + (col >> 2)) * 2 + which) * 4 + (col & 3)];
                WSP(float, WS_C12)[which * D + bx * 32 + col] = a; }
            __syncthreads();
        }
        for (int row = gw; row < T; row += NGW) {
            const bf16* pr = proj + (size_t)row * NPROJ;
            v4u aw[4], hw[4], grw[4], hgw[4], maw[4], mbw[4];
#pragma unroll
            for (int j2 = 0; j2 < 4; ++j2) { const int c = 8 * lane + 512 * j2; aw[j2] = *(const v4u*)((const bf16*)ogla + (size_t)row * D + c); hw[j2] = *(const v4u*)((const bf16*)oh + (size_t)row * D + c);
                grw[j2] = *(const v4u*)(pr + GR + c); hgw[j2] = *(const v4u*)(pr + HG + c); maw[j2] = *(const v4u*)(pr + MA + c); mbw[j2] = *(const v4u*)(pr + MB + c); }
#pragma unroll
            for (int j2 = 0; j2 < 4; ++j2) {
                int lo8 = 8 * lane; asm volatile("" : "+v"(lo8));
                const f32x4 gn0 = *(const f32x4*)(gla_g + lo8), gn1 = *(const f32x4*)(gla_g + lo8 + 4), hn0 = *(const f32x4*)(hgrn_g + (lo8 & 127)), hn1 = *(const f32x4*)(hgrn_g + (lo8 & 127) + 4);
                f32x4 a0, a1, h0, h1_, g0, g1, q0, q1, m0, m1, n0, n1;
                bf16x8_to_f32(aw[j2], a0, a1); bf16x8_to_f32(hw[j2], h0, h1_); bf16x8_to_f32(grw[j2], g0, g1); bf16x8_to_f32(hgw[j2], q0, q1); bf16x8_to_f32(maw[j2], m0, m1); bf16x8_to_f32(mbw[j2], n0, n1);
                float sg = ((a0[0] * a0[0] + a0[1] * a0[1]) + (a0[2] * a0[2] + a0[3] * a0[3])) + ((a1[0] * a1[0] + a1[1] * a1[1]) + (a1[2] * a1[2] + a1[3] * a1[3]));
                const float rg = __builtin_amdgcn_rsqf(wave_sum(sg) * (1.0f / 512.0f) + EPS);
                float sh = ((h0[0] * h0[0] + h0[1] * h0[1]) + (h0[2] * h0[2] + h0[3] * h0[3])) + ((h1_[0] * h1_[0] + h1_[1] * h1_[1]) + (h1_[2] * h1_[2] + h1_[3] * h1_[3]));
                sh += __shfl_xor(sh, 1); sh += __shfl_xor(sh, 2); sh += __shfl_xor(sh, 4); sh += __shfl_xor(sh, 8);
                const float rh = __builtin_amdgcn_rsqf(sh * (1.0f / 128.0f) + EPS);
                f32x4 o0, o1;
#pragma unroll
                for (int k = 0; k < 4; ++k) {
                    o0[k] = sigmoidf_(m0[k]) * (a0[k] * rg * gn0[k] * (g0[k] * sigmoidf_(g0[k]))) + sigmoidf_(n0[k]) * (h0[k] * rh * hn0[k] * sigmoidf_(q0[k]));
                    o1[k] = sigmoidf_(m1[k]) * (a1[k] * rg * gn1[k] * (g1[k] * sigmoidf_(g1[k]))) + sigmoidf_(n1[k]) * (h1_[k] * rh * hn1[k] * sigmoidf_(q1[k])); }
                v4u w; w.x = pk2(o0[0], o0[1]); w.y = pk2(o0[2], o0[3]); w.z = pk2(o1[0], o1[1]); w.w = pk2(o1[2], o1[3]);
                *(v4u*)(merged + (size_t)row * D + 8 * lane + 512 * j2) = w;
                if (j2 & 1) __builtin_amdgcn_sched_barrier(0);
            }
        }
    }
    SEAM(5);
    if (IN(6)) {
        pg8::SchedDense S{(const char*)merged, (const char*)Wo_t, T / 256, D / 256, G, bx, (size_t)256 * D * 2, (size_t)256 * D * 2};
        pg8::EpiPre1 E{(bf16*)pre1, (unsigned char*)h1, D, x_in, ALPHA, WSP(float, WS_STAT)};
        pg8::gemm_phase<pg8::EpiPre1, pg8::SchedDense, false>(lds, D, D, D, S, E);
    }
    SEAM(6);
    const bool own_chain = IN(8) && IN(9) && IN(11) && G == 256;
    if (IN(7) && !own_chain) {
        for (int row = bx * 512 + tid; row < T; row += G * 512) ln1_finish(WSP(float, WS_STAT), WSP(float, WS_FST), row);
    }
    if (!own_chain) SEAM(7);
    if (own_chain) {
        pg8::Unit u0; pg8::static_next(T / 256, XH, G, bx, 0, u0);
        const int opm = __builtin_amdgcn_readfirstlane(u0.pm), oh_ = __builtin_amdgcn_readfirstlane(u0.pn);
        if (tid < 256) ln1_finish(WSP(float, WS_STAT), WSP(float, WS_FST) + (size_t)oh_ * T * 2, opm * 256 + tid);
        __syncthreads();
        {   pg8::SchedOwn<pg8::SchedDense> S{{(const char*)h1, (const char*)Wxq_t, T / 256, D / 256, G, bx, (size_t)256 * D, (size_t)256 * D}, opm, 2 * oh_, 2};
            int oh2 = oh_; asm volatile("" : "+s"(oh2));
            pg8::EpiQFold E{qb, D, WSP(float, WS_FST) + (size_t)oh2 * T * 2, WSP(float, WS_C12), WSP(float, WS_C12) + D, 0.04419417382415922f, 1.0f / 256.0f};
            pg8::gemm_phase<pg8::EpiQFold, pg8::SchedOwn<pg8::SchedDense>, false, 1>(lds, D, D, D, S, E); }
        {   pg8::SchedOwn<pg8::SchedScores> S{{(const char*)qb, (const char*)kk, G, bx}, opm, oh_, 1};
            pg8::EpiSoftmax E{Pb, 1024, (LAS float*)(lds + RING_BYTES)};
            pg8::gemm_phase<pg8::EpiSoftmax, pg8::SchedOwn<pg8::SchedScores>, false>(lds, XDH, D, D, S, E); }
        {   pg8::SchedOwn<pg8::SchedPV> S{{(const char*)Pb, (const char*)vt, G, bx}, opm, 2 * oh_, 2};
            pg8::EpiFp8 E{(unsigned char*)ao, D, 16.0f};
            pg8::gemm_phase<pg8::EpiFp8, pg8::SchedOwn<pg8::SchedPV>, false>(lds, NMEM, 1024, 512, S, E); }
    } else {
    if (IN(8)) {
        pg8::SchedDense S{(const char*)h1, (const char*)Wxq_t, T / 256, D / 256, G, bx, (size_t)256 * D, (size_t)256 * D};
        pg8::EpiQFold E{qb, D, WSP(float, WS_FST), WSP(float, WS_C12), WSP(float, WS_C12) + D, 0.04419417382415922f, 1.0f / 256.0f};
        pg8::gemm_phase<pg8::EpiQFold, pg8::SchedDense, false, 1>(lds, D, D, D, S, E);
    }
    SEAM(8);
    if (IN(9)) {
        pg8::SchedScores S{(const char*)qb, (const char*)kk, G, bx};
        pg8::EpiSoftmax E{Pb, 1024, (LAS float*)(lds + RING_BYTES)};
        pg8::gemm_phase<pg8::EpiSoftmax, pg8::SchedScores, false>(lds, XDH, D, D, S, E);
    }
    if (IN(9) && IN(11)) xcd_barrier(bar);
    if (IN(11)) {
        pg8::SchedPV S{(const char*)Pb, (const char*)vt, G, bx};
        pg8::EpiFp8 E{(unsigned char*)ao, D, 16.0f};
        pg8::gemm_phase<pg8::EpiFp8, pg8::SchedPV, false>(lds, NMEM, 1024, 512, S, E);
    }
    }
    SEAM(11);
    if (IN(12)) {
        pg8::SchedDense S{(const char*)ao, (const char*)Wxo_t, T / 256, D / 256, G, bx, (size_t)256 * D, (size_t)256 * D};
        pg8::EpiXoFold E{(bf16*)pre2, D, (const bf16*)pre1, WSP(float, WS_FST), ln1_g, ln1_b, ALPHA, 1.0f / 4096.0f};
        pg8::gemm_phase<pg8::EpiXoFold, pg8::SchedDense, false, 1>(lds, D, D, D, S, E);
    }
    SEAM(12);
    if (IN(13)) {
        LAS int* lcnt = (LAS int*)(lds);
        LAS int* lbase = (LAS int*)(lds + 128);
        LAS int* lsel = (LAS int*)(lds + 256);
        constexpr int ARS = 4096 + 16;
        LAS unsigned char* AH = lds + 4096; LAS unsigned char* AL = lds + 4096 + 16 * ARS;
        LAS float* PART = (LAS float*)(lds + 4096 + 32 * ARS);
        const bool side = !(args.flags & 4);
#define ROUTER_LN(p_, q_) do { const int lr_ = 2 * wave + (q_); const int row_ = rb * 64 + (p_) * 16 + lr_; f32x4 v[8]; int lane_ = lane; asm volatile("" : "+v"(lane_));        \
            _Pragma("unroll") for (int j2 = 0; j2 < 4; ++j2) bf16x8_to_f32(raw[q_][j2], v[2 * j2], v[2 * j2 + 1]); float mu_, rs_; ln_apply_b_st(v, ln2_g, ln2_b, lane_, mu_, rs_); if (lane == 0) *(f32x2*)(WSP(float, WS_ST2) + 2 * (size_t)row_) = (f32x2){mu_, rs_}; \
            _Pragma("unroll") for (int j2 = 0; j2 < 4; ++j2) { const f32x4 a_ = v[2 * j2], b_ = v[2 * j2 + 1]; v4u hi_, lo_; \
                hi_.x = pk2(a_[0], a_[1]); hi_.y = pk2(a_[2], a_[3]); hi_.z = pk2(b_[0], b_[1]); hi_.w = pk2(b_[2], b_[3]); \
                lo_.x = pk2(a_[0] - __uint_as_float(hi_.x << 16), a_[1] - __uint_as_float(hi_.x & 0xffff0000u)); lo_.y = pk2(a_[2] - __uint_as_float(hi_.y << 16), a_[3] - __uint_as_float(hi_.y & 0xffff0000u)); \
                lo_.z = pk2(b_[0] - __uint_as_float(hi_.z << 16), b_[1] - __uint_as_float(hi_.z & 0xffff0000u)); lo_.w = pk2(b_[2] - __uint_as_float(hi_.w << 16), b_[3] - __uint_as_float(hi_.w & 0xffff0000u)); \
                v2u w8_; w8_.x = pk4_fp8(a_[0], a_[1], a_[2], a_[3]); w8_.y = pk4_fp8(b_[0], b_[1], b_[2], b_[3]); \
                *(v2u*)((unsigned char*)h2b + (size_t)row_ * D + 8 * lane_ + 512 * j2) = w8_; \
                *(LAS v4u*)(AH + lr_ * ARS + (8 * lane_ + 512 * j2) * 2) = hi_; *(LAS v4u*)(AL + lr_ * ARS + (8 * lane_ + 512 * j2) * 2) = lo_; } } while (0)
        const int fr = lane & 15, fq = lane >> 4;
        for (int rb = bx; rb < T / 64; rb += G) {
            if (tid < 32) lcnt[tid] = 0;
            v4u raw[2][4];
#define ROUTER_FETCH(p_) do { _Pragma("unroll") for (int q = 0; q < 2; ++q) _Pragma("unroll") for (int j2 = 0; j2 < 4; ++j2) \
                raw[q][j2] = *(const v4u*)((const bf16*)pre2 + (size_t)(rb * 64 + (p_) * 16 + 2 * wave + q) * D + 8 * lane + 512 * j2); } while (0)
            ROUTER_FETCH(0);
#pragma nounroll
            for (int ps = 0; ps < 4; ++ps) {
                bf16x8 bh0[4][2], bl0[4][2];
                unsigned boff = (unsigned)((fr * D + 256 * wave + 8 * fq) * 2); asm volatile("" : "+v"(boff));
#pragma unroll
                for (int ks = 0; ks < 4; ++ks)
#pragma unroll
                    for (int nt = 0; nt < 2; ++nt) { bh0[ks][nt] = *(const bf16x8*)((const char*)(WSP(bf16, WS_WRH) + nt * 16 * D) + boff + 64 * ks); bl0[ks][nt] = *(const bf16x8*)((const char*)(WSP(bf16, WS_WRL) + nt * 16 * D) + boff + 64 * ks); }
                ROUTER_LN(ps, 0);
                ROUTER_LN(ps, 1);
                if (ps + 1 < 4) ROUTER_FETCH(ps + 1);
                __syncthreads();
                {   bf16x8 bh1[4][2], bl1[4][2];
#pragma unroll
                    for (int ks = 0; ks < 4; ++ks)
#pragma unroll
                        for (int nt = 0; nt < 2; ++nt) { bh1[ks][nt] = *(const bf16x8*)((const char*)(WSP(bf16, WS_WRH) + nt * 16 * D) + boff + 64 * (ks + 4)); bl1[ks][nt] = *(const bf16x8*)((const char*)(WSP(bf16, WS_WRL) + nt * 16 * D) + boff + 64 * (ks + 4)); }
                    f32x4 acc[2] = {{0.f, 0.f, 0.f, 0.f}, {0.f, 0.f, 0.f, 0.f}};
                    const LAS unsigned char* ah = AH + fr * ARS + (256 * wave + 8 * fq) * 2; const LAS unsigned char* al = AL + fr * ARS + (256 * wave + 8 * fq) * 2;
#pragma unroll
                    for (int ks = 0; ks < 4; ++ks) { const bf16x8 xh = *(const LAS bf16x8*)(ah + 64 * ks), xl = *(const LAS bf16x8*)(al + 64 * ks);
#pragma unroll
                        for (int nt = 0; nt < 2; ++nt) { acc[nt] = __builtin_amdgcn_mfma_f32_16x16x32_bf16(bl0[ks][nt], xh, acc[nt], 0, 0, 0); acc[nt] = __builtin_amdgcn_mfma_f32_16x16x32_bf16(bh0[ks][nt], xl, acc[nt], 0, 0, 0);
                            acc[nt] = __builtin_amdgcn_mfma_f32_16x16x32_bf16(bh0[ks][nt], xh, acc[nt], 0, 0, 0); } }
#pragma unroll
                    for (int ks = 0; ks < 4; ++ks) { const bf16x8 xh = *(const LAS bf16x8*)(ah + 64 * (ks + 4)), xl = *(const LAS bf16x8*)(al + 64 * (ks + 4));
#pragma unroll
                        for (int nt = 0; nt < 2; ++nt) { acc[nt] = __builtin_amdgcn_mfma_f32_16x16x32_bf16(bl1[ks][nt], xh, acc[nt], 0, 0, 0); acc[nt] = __builtin_amdgcn_mfma_f32_16x16x32_bf16(bh1[ks][nt], xl, acc[nt], 0, 0, 0);
                            acc[nt] = __builtin_amdgcn_mfma_f32_16x16x32_bf16(bh1[ks][nt], xh, acc[nt], 0, 0, 0); } }
                    *(LAS f32x4*)(PART + (wave * 16 + fr) * 32 + 4 * fq) = acc[0]; *(LAS f32x4*)(PART + (wave * 16 + fr) * 32 + 16 + 4 * fq) = acc[1];
                }
                __syncthreads();
                {   const int hs = lane >> 5, lr = 2 * wave + hs, rr = ps * 16 + lr, row = rb * 64 + rr, e = lane & 31;
                    float lg = b_router[e];
#pragma unroll
                    for (int w8 = 0; w8 < 8; ++w8) lg += PART[(w8 * 16 + lr) * 32 + e];
                    float tl[4]; int te[4]; float val = lg;
#pragma unroll
                    for (int k = 0; k < 4; ++k) { float m = val; m = fmaxf(m, __shfl_xor(m, 1)); m = fmaxf(m, __shfl_xor(m, 2)); m = fmaxf(m, __shfl_xor(m, 4)); m = fmaxf(m, __shfl_xor(m, 8)); m = fmaxf(m, __shfl_xor(m, 16));
                        const unsigned long long bal = __ballot(val == m); const unsigned b32 = hs ? (unsigned)(bal >> 32) : (unsigned)bal; const int bi = (int)__builtin_ctz(b32) & 31;
                        tl[k] = m; te[k] = bi; if (e == bi) val = -3.0e38f; }
                    const float e1 = __expf(tl[1] - tl[0]), e2 = __expf(tl[2] - tl[0]), e3 = __expf(tl[3] - tl[0]); const float inv = 1.0f / (1.0f + e1 + e2 + e3);
                    if (e < 4) { const int ex = e == 0 ? te[0] : (e == 1 ? te[1] : (e == 2 ? te[2] : te[3])); const float gt = (e == 0 ? 1.0f : (e == 1 ? e1 : (e == 2 ? e2 : e3))) * inv;
                        gates[(size_t)row * 4 + e] = gt; if (side) { const int sl = __hip_atomic_fetch_add(&lcnt[ex], 1, __ATOMIC_RELAXED, __HIP_MEMORY_SCOPE_WORKGROUP); lsel[rr * 4 + e] = ex | (sl << 8); } }
                }
            }
            __syncthreads();
            if (tid < 32 && side) lbase[tid] = (int)atomicAdd(&ecnt[tid], (unsigned)lcnt[tid]);
            __syncthreads();
            if (tid < 256 && side) { const int s_ = lsel[tid]; const int e = s_ & 255, sl = s_ >> 8; list[e * MOE_CAP + lbase[e] + sl] = (rb * 64 + (tid >> 2)) * 4 + (tid & 3); }
            __syncthreads();
        }
    }
#undef ROUTER_LN
#undef ROUTER_FETCH
    SEAM(13);
    if (IN(14) || IN(15)) {
        LAS int* tab = (LAS int*)(lds + MOETAB_OFF);
        if (tid < 64) {
            const int e = tid & 31; const int c = (int)__hip_atomic_load(&ecnt[e], RLX_AGENT); const int te = (c + 255) >> 8; int v = te;
#pragma unroll
            for (int o = 1; o < 32; o <<= 1) { const int t = __shfl(v, (tid - o) & 63); if (e >= o) v += t; }
            if (tid < 32) { tab[e] = v - te; tab[33 + e] = c; if (e == 31) tab[32] = v; } }
        __syncthreads();
        if (IN(14)) {
            LAS unsigned short* toks = (LAS unsigned short*)(lds + RING_BYTES);
            {
                pg8::SchedMoe S0{tab, nullptr, nullptr, list, 16, G, bx, 0, 1, nullptr};
                const int r_ = tid & 255, hsel = __builtin_amdgcn_readfirstlane(tid >> 8);
#pragma nounroll
                for (int i0 = 0; i0 < 32; i0 += 8) {
                    int av[4];
#pragma unroll
                    for (int k = 0; k < 4; ++k) { pg8::Unit u0; av[k] = -1; if (S0.next(i0 + 2 * k + hsel, u0)) { av[k] = 0; if (r_ < u0.rows) av[k] = list[u0.e * MOE_CAP + u0.mt * 256 + r_]; } }
#pragma unroll
                    for (int k = 0; k < 4; ++k) if (av[k] >= 0) toks[(i0 + 2 * k + hsel) * 256 + r_] = (unsigned short)(av[k] >> 2);
                    pg8::Unit u1; if (!S0.next(i0 + 8, u1)) break;
                }
                __syncthreads(); }
            pg8::SchedMoe S{tab, (const char*)h2b, (const char*)Wgu_t, list, 16, G, bx, (size_t)4096 * D, 1, G >= 160 ? toks : (LAS unsigned short*)nullptr};
            pg8::EpiSwiglu E{act, bgup, 1.0f / 256.0f};
            pg8::gemm_phase<pg8::EpiSwiglu, pg8::SchedMoe, true, 1>(lds, D, D, D, S, E);
        }
        SEAM(14);
        if (IN(15)) {
            LAS int* tA = (LAS int*)(lds + RING_BYTES); LAS float* tG = (LAS float*)(lds + RING_BYTES + 12 * 1024);
            const bool tok = G >= 216;
            if (tok) {
                pg8::SchedMoe S0{tab, nullptr, nullptr, list, 8, G, bx, 0, 1, nullptr};
                const int r_ = tid & 255, hsel = __builtin_amdgcn_readfirstlane(tid >> 8);
                int av[6]; float gv[6]; bool ok[6];
#pragma unroll
                for (int k = 0; k < 6; ++k) { pg8::Unit u0; av[k] = -1; ok[k] = S0.next(2 * k + hsel, u0); if (ok[k] && r_ < u0.rows) av[k] = list[u0.e * MOE_CAP + u0.mt * 256 + r_]; }
#pragma unroll
                for (int k = 0; k < 6; ++k) { gv[k] = 0.f; if (av[k] >= 0) gv[k] = gates[av[k]]; }
#pragma unroll
                for (int k = 0; k < 6; ++k) if (ok[k]) { tA[(2 * k + hsel) * 256 + r_] = av[k]; tG[(2 * k + hsel) * 256 + r_] = gv[k]; }
                __syncthreads(); }
            pg8::SchedMoe S{tab, (const char*)act, (const char*)Wd_t, nullptr, 8, G, bx, (size_t)D * D, 1, nullptr};
            pg8::EpiDown E{ybuf, b_down, list, gates, 1.0f / 256.0f, tok ? tA : (LAS int*)nullptr, tok ? tG : (LAS float*)nullptr};
            pg8::gemm_phase<pg8::EpiDown, pg8::SchedMoe, false, 1>(lds, D, D, D, S, E);
        }
    }
    SEAM(15);
    if (IN(16)) {
        v4u hw[4]; v2u yw[4][4]; f32x2 st2;
#define P16_FETCH(r_) do { _Pragma("unroll") for (int j2 = 0; j2 < 4; ++j2) { hw[j2] = *(const v4u*)((const bf16*)pre2 + (size_t)(r_) * D + 8 * lane + 512 * j2); \
            _Pragma("unroll") for (int k = 0; k < 4; ++k) yw[j2][k] = *(const v2u*)((const unsigned char*)ybuf + ((size_t)(r_) * 4 + k) * D + 8 * lane + 512 * j2); } \
            st2 = *(const f32x2*)(WSP(float, WS_ST2) + 2 * (size_t)(r_)); } while (0)
        if (gw < T) P16_FETCH(gw);
        for (int row = gw; row < T; row += NGW) {
            f32x4 v[8];
#pragma unroll
            for (int j2 = 0; j2 < 4; ++j2) { f32x4 a0, a1; bf16x8_to_f32(hw[j2], a0, a1);
                {
                    const f32x4 g0 = *(const f32x4*)(ln2_g + COLB(2 * j2)), g1 = *(const f32x4*)(ln2_g + COLB(2 * j2 + 1)), b0 = *(const f32x4*)(ln2_b + COLB(2 * j2)), b1 = *(const f32x4*)(ln2_b + COLB(2 * j2 + 1));
                    a0 = ((a0 - st2[0]) * st2[1] * g0 + b0) * ALPHA; a1 = ((a1 - st2[0]) * st2[1] * g1 + b1) * ALPHA; }
#pragma unroll
                for (int k = 0; k < 4; ++k) { const v2u w = yw[j2][k];
                    const f32x2 p0 = __builtin_amdgcn_cvt_pk_f32_fp8(w.x, false), p1 = __builtin_amdgcn_cvt_pk_f32_fp8(w.x, true), p2 = __builtin_amdgcn_cvt_pk_f32_fp8(w.y, false), p3 = __builtin_amdgcn_cvt_pk_f32_fp8(w.y, true);
                    a0 = a0 + (f32x4){p0[0], p0[1], p1[0], p1[1]} * 0.0625f; a1 = a1 + (f32x4){p2[0], p2[1], p3[0], p3[1]} * 0.0625f; }
                v[2 * j2] = a0; v[2 * j2 + 1] = a1; }
            if (row + NGW < T) P16_FETCH(row + NGW);
            ln_apply_b(v, ln3_g, ln3_b, lane);
#pragma unroll
            for (int j = 0; j < 8; ++j) __builtin_nontemporal_store(v[j], (f32x4*)(args.out + (size_t)row * D + COLB(j)));
        }
#undef P16_FETCH
    }
#undef IN
#undef SEAM
}
#undef x_in
#undef mem_in
#undef w_in
#undef b_in
#undef w_a2
#undef b_a
#undef gla_g
#undef hgrn_g
#undef lb_logits
#undef w_mix_o
#undef w_xq
#undef w_mem_kv
#undef w_xo
#undef w_router
#undef b_router
#undef w_gate_up
#undef b_gate_up
#undef w_down
#undef b_down
#undef ln1_g
#undef ln1_b
#undef ln2_g
#undef ln2_b
#undef ln3_g
#undef ln3_b
#undef Win_t
#undef Wo_t
#undef Wxq_t
#undef Wkv_t
#undef Wxo_t
#undef Wgu_t
#undef Wd_t
#undef xb
#undef memb
#undef ga1
#undef binc
#undef bgup
#undef lbt
#undef proj
#undef glog
#undef ogla
#undef oh
#undef merged
#undef pre1
#undef h1
#undef h1b
#undef qb
#undef kk
#undef vt
#undef sc
#undef Pb
#undef ao
#undef pre2
#undef h2
#undef h2b
#undef list
#undef gates
#undef act
#undef ybuf
#undef ecnt
#undef WSP
#undef ws_

extern "C" void kernel_launch(void* const* d_in, const int* in_sizes, int n_in, void* d_out, int out_size, void* d_ws, size_t ws_size, hipStream_t stream) {
    static int grid = 0;
    if (grid == 0) {
        if (n_in != 25 || out_size != T * D || ws_size < WS_END) { fprintf(stderr, "kernel_launch: unexpected problem: n_in %d out %d ws %zu (need %zu)\n", n_in, out_size, ws_size, (size_t)WS_END); grid = -1; return; }
        int dev = 0, cus = 0, per_cu = 0;
        if (hipGetDevice(&dev) != hipSuccess || hipDeviceGetAttribute(&cus, hipDeviceAttributeMultiprocessorCount, dev) != hipSuccess) { grid = -1; return; }
        if (hipFuncSetAttribute((const void*)fwd_kernel, hipFuncAttributeMaxDynamicSharedMemorySize, LDS_BYTES) != hipSuccess) { fprintf(stderr, "kernel_launch: hipFuncSetAttribute failed\n"); grid = -1; return; }
        if (hipOccupancyMaxActiveBlocksPerMultiprocessor(&per_cu, (const void*)fwd_kernel, NTHREADS, LDS_BYTES) != hipSuccess || per_cu < 1) { fprintf(stderr, "kernel_launch: occupancy query says %d\n", per_cu); }
        (void)hipGetLastError();
        grid = cus;
    }
    if (grid < 0) return;
    (void)hipMemsetAsync((char*)d_ws + WS_CTL, 0, CTL_ZERO_BYTES, stream);
    Args a{};
    for (int i = 0; i < 25; ++i) a.in[i] = (const float*)d_in[i];
    a.out = (float*)d_out; a.ws = (unsigned char*)d_ws;
#if MK_ONE_LAUNCH
    a.ph_lo = 0; a.ph_hi = N_PHASES;
    hipLaunchKernelGGL(fwd_kernel, dim3(grid), dim3(NTHREADS), LDS_BYTES, stream, a);
#ifdef PROBE_PHASE
    a.ph_lo = PROBE_PHASE; a.ph_hi = PROBE_PHASE + 1;
#ifdef PROBE_FLAGS
    a.flags = PROBE_FLAGS;
#endif
    hipLaunchKernelGGL(fwd_kernel, dim3(grid), dim3(NTHREADS), LDS_BYTES, stream, a);
#endif
#else
    for (int p = 0; p < N_PHASES; ++p) { a.ph_lo = p; a.ph_hi = p + 1; hipLaunchKernelGGL(fwd_kernel, dim3(grid), dim3(NTHREADS), LDS_BYTES, stream, a); }
#endif
}
```
